# Optimizing an MI355X kernel written in HIP

```python
import math
import jax, jax.numpy as jnp
from jax import lax
import numpy as np

D_MODEL = 1024
BATCH = 16
SEQ = 2048
DEPTH = 2

HEAD_DIM = 64
Q_BLOCK = 128
SCALE = HEAD_DIM ** -0.5
A_HEADS = 4
B_HEADS = 6
C_HEADS = 6
D_PAIRS = ((128, 1), (512, 4), (2048, 16))
D_GROUPS = len(D_PAIRS)
D_HEADS_PER_GROUP = 2
D_HEADS = D_GROUPS * D_HEADS_PER_GROUP
N_BRANCH = 4
FFN_HIDDEN = 2816
REL_BUCKETS = 32
REL_MAX_DIST = 128
REL_HEADS = A_HEADS + D_HEADS
RMS_EPS = 1e-6
NEG_INF = -1e30
IN_SPLITS = (
    A_HEADS * 2 * HEAD_DIM, A_HEADS * 2 * HEAD_DIM, A_HEADS * 2 * HEAD_DIM,
    B_HEADS * HEAD_DIM, B_HEADS * HEAD_DIM, B_HEADS * HEAD_DIM,
    C_HEADS * HEAD_DIM, C_HEADS * HEAD_DIM, C_HEADS * HEAD_DIM, C_HEADS,
    D_HEADS * HEAD_DIM, D_HEADS * HEAD_DIM, D_HEADS * HEAD_DIM,
    N_BRANCH * D_MODEL,
)
D_IN = sum(IN_SPLITS)
BRANCH_WIDTHS = (A_HEADS * 2 * HEAD_DIM, B_HEADS * HEAD_DIM, C_HEADS * HEAD_DIM, D_HEADS_PER_GROUP * HEAD_DIM)

kernel_name = 'hybrid_gated_parallel_mixers'


def _offsets(sizes):
    return [int(v) for v in np.cumsum(sizes)[:-1]]


def rms_norm(x, g):
    xf = x.astype(jnp.float32)
    y = xf * lax.rsqrt(jnp.mean(xf * xf, axis=-1, keepdims=True) + RMS_EPS)
    return (y * g.astype(jnp.float32)).astype(x.dtype)


def swiglu(h, w_i, w_o):
    gate, up = jnp.split(h @ w_i, 2, axis=-1)
    return (jax.nn.silu(gate) * up) @ w_o


def split_heads(t, n):
    b, s, _ = t.shape
    return t.reshape(b, s, n, -1).transpose(0, 2, 1, 3)


def merge_heads(t):
    b, h, s, d = t.shape
    return t.transpose(0, 2, 1, 3).reshape(b, s, h * d)


def rel_bucket(n):
    max_exact = REL_BUCKETS // 2
    nf = jnp.maximum(n, 1).astype(jnp.float32)
    large = max_exact + (jnp.log(nf / max_exact) / math.log(REL_MAX_DIST / max_exact)
                         * (REL_BUCKETS - max_exact)).astype(jnp.int32)
    large = jnp.minimum(large, REL_BUCKETS - 1)
    return jnp.where(n < max_exact, n, large)


def causal_rel_bias(table, q0, kv_len):
    n = (q0 + jnp.arange(Q_BLOCK))[:, None] - jnp.arange(kv_len)[None, :]
    return jnp.moveaxis(table[rel_bucket(jnp.maximum(n, 0))], -1, 0).astype(jnp.float32)


def causal_mask(q0, kv_len, strict):
    t = (q0 + jnp.arange(Q_BLOCK))[:, None]
    s = jnp.arange(kv_len)[None, :]
    return s < t if strict else s <= t


def sweep_blocks(block_fn, seq):
    return jnp.concatenate([block_fn(i * Q_BLOCK, (i + 1) * Q_BLOCK) for i in range(seq // Q_BLOCK)], axis=2)


def diff_attention(q, k, v, q_gain, k_gain, lam_vecs, subln_gain, rel_table, lam_init):
    b, s, _ = q.shape
    q = rms_norm(q.reshape(b, s, A_HEADS, 2, HEAD_DIM), q_gain).transpose(0, 3, 2, 1, 4)
    k = rms_norm(k.reshape(b, s, A_HEADS, 2, HEAD_DIM), k_gain).transpose(0, 3, 2, 1, 4)
    v = split_heads(v, A_HEADS)
    lv = lam_vecs.astype(jnp.float32)
    lam = jnp.exp(jnp.sum(lv[0] * lv[1])) - jnp.exp(jnp.sum(lv[2] * lv[3])) + lam_init

    def block(q0, kv_len):
        sc = jnp.einsum('bmhqd,bmhkd->bmhqk', q[:, :, :, q0:q0 + Q_BLOCK], k[:, :, :, :kv_len],
                        preferred_element_type=jnp.float32) * SCALE + causal_rel_bias(rel_table, q0, kv_len)
        p = jax.nn.softmax(jnp.where(causal_mask(q0, kv_len, False), sc, NEG_INF), axis=-1)
        w = p[:, 0] - lam * p[:, 1]
        return jnp.einsum('bhqk,bhkd->bhqd', w.astype(v.dtype), v[:, :, :kv_len])

    o = sweep_blocks(block, s)
    o = rms_norm(o, subln_gain) * (1.0 - lam_init)
    return merge_heads(o)


def stick_breaking_attention(q, k, v):
    b, s, _ = q.shape
    q, k, v = split_heads(q, B_HEADS), split_heads(k, B_HEADS), split_heads(v, B_HEADS)

    def block(q0, kv_len):
        z = jnp.einsum('bhqd,bhkd->bhqk', q[:, :, q0:q0 + Q_BLOCK], k[:, :, :kv_len],
                       preferred_element_type=jnp.float32) * SCALE
        mask = causal_mask(q0, kv_len, True)
        u = jnp.where(mask, jax.nn.log_sigmoid(-z), 0.0)
        tail = lax.cumsum(u, axis=3, reverse=True) - u
        a = jnp.where(mask, jnp.exp(jax.nn.log_sigmoid(z) + tail), 0.0)
        return jnp.einsum('bhqk,bhkd->bhqd', a.astype(v.dtype), v[:, :, :kv_len])

    return merge_heads(sweep_blocks(block, s))


def forgetting_attention(q, k, v, f_logit, f_bias, q_gain, k_gain):
    b, s, _ = q.shape
    q = rms_norm(q.reshape(b, s, C_HEADS, HEAD_DIM), q_gain).transpose(0, 2, 1, 3)
    k = rms_norm(k.reshape(b, s, C_HEADS, HEAD_DIM), k_gain).transpose(0, 2, 1, 3)
    v = split_heads(v, C_HEADS)
    log_f = jax.nn.log_sigmoid((f_logit + f_bias).astype(jnp.float32))
    cum = jnp.cumsum(log_f, axis=1).transpose(0, 2, 1)

    def block(q0, kv_len):
        sc = jnp.einsum('bhqd,bhkd->bhqk', q[:, :, q0:q0 + Q_BLOCK], k[:, :, :kv_len],
                        preferred_element_type=jnp.float32) * SCALE
        sc = sc + cum[:, :, q0:q0 + Q_BLOCK, None] - cum[:, :, None, :kv_len]
        p = jax.nn.softmax(jnp.where(causal_mask(q0, kv_len, False), sc, NEG_INF), axis=-1)
        return jnp.einsum('bhqk,bhkd->bhqd', p.astype(v.dtype), v[:, :, :kv_len])

    return merge_heads(sweep_blocks(block, s))


def dilated_attention(q, k, v, q_gain, k_gain, rel_table):
    b, s, _ = q.shape
    shape5 = (b, s, D_GROUPS, D_HEADS_PER_GROUP, HEAD_DIM)
    q = rms_norm(q.reshape(shape5), q_gain)
    k = rms_norm(k.reshape(shape5), k_gain)
    v = v.reshape(shape5)
    outs, lses = [], []
    for g, (window, dilation) in enumerate(D_PAIRS):
        dist = dilation * jnp.arange(window // dilation + 1)
        bias = rel_table[rel_bucket(dist)][:, g * D_HEADS_PER_GROUP:(g + 1) * D_HEADS_PER_GROUP]
        bias = bias.T.astype(jnp.float32)
        qg, kg, vg = q[:, :, g], k[:, :, g], v[:, :, g]

        def block(q0):
            pos = q0 + jnp.arange(Q_BLOCK)[:, None] - dist[None, :]
            valid = pos >= 0
            idx = jnp.maximum(pos, 0)
            kb = jnp.take(kg, idx, axis=1)
            vb = jnp.take(vg, idx, axis=1)
            qb = lax.dynamic_slice_in_dim(qg, q0, Q_BLOCK, axis=1)
            sc = jnp.einsum('bqhd,bqkhd->bhqk', qb, kb, preferred_element_type=jnp.float32) * SCALE
            sc = jnp.where(valid, sc + bias[None, :, None, :], NEG_INF)
            m = jnp.max(sc, axis=-1, keepdims=True)
            e = jnp.exp(sc - m)
            l = jnp.sum(e, axis=-1, keepdims=True)
            o = jnp.einsum('bhqk,bqkhd->bqhd', (e / l).astype(vg.dtype), vb)
            lse = (m + jnp.log(l))[..., 0].transpose(0, 2, 1)
            return o, lse

        o, lse = lax.map(block, jnp.arange(s // Q_BLOCK) * Q_BLOCK)
        outs.append(o.transpose(1, 0, 2, 3, 4).reshape(b, s, D_HEADS_PER_GROUP, HEAD_DIM))
        lses.append(lse.transpose(1, 0, 2, 3).reshape(b, s, D_HEADS_PER_GROUP))
    alpha = jax.nn.softmax(jnp.stack(lses), axis=0)
    o = jnp.sum(alpha[..., None] * jnp.stack(outs).astype(jnp.float32), axis=0)
    return o.reshape(b, s, -1).astype(v.dtype)


def setup_inputs(seed: int = 0) -> dict:
    key = jax.random.key(seed)
    ks = iter(jax.random.split(key, 32))
    L, D = DEPTH, D_MODEL

    def nrm(shape, scale):
        return jax.random.normal(next(ks), shape, jnp.float32) * scale

    def gain(shape):
        return 1.0 + nrm(shape, 0.02)

    return {
        'x': nrm((BATCH, SEQ, D), 1.0),
        'rel_table': nrm((REL_BUCKETS, REL_HEADS), 0.2),
        'ffn1_norm': gain((L, D)),
        'ffn1_w_in': nrm((L, D, 2 * FFN_HIDDEN), D ** -0.5),
        'ffn1_w_out': nrm((L, FFN_HIDDEN, D), FFN_HIDDEN ** -0.5),
        'mix_norm': gain((L, D)),
        'w_in': nrm((L, D, D_IN), D ** -0.5),
        'gate_bias': nrm((L, N_BRANCH * D), 0.02),
        'forget_bias': 2.0 + nrm((L, C_HEADS), 0.1),
        'a_q_norm': gain((L, HEAD_DIM)),
        'a_k_norm': gain((L, HEAD_DIM)),
        'a_lambda': nrm((L, 4, HEAD_DIM), 0.1),
        'a_subln': gain((L, 2 * HEAD_DIM)),
        'c_q_norm': gain((L, HEAD_DIM)),
        'c_k_norm': gain((L, HEAD_DIM)),
        'd_q_norm': gain((L, HEAD_DIM)),
        'd_k_norm': gain((L, HEAD_DIM)),
        'w_branch': jnp.concatenate([nrm((L, w, D), w ** -0.5) for w in BRANCH_WIDTHS], axis=1),
        'w_out': nrm((L, D, D), D ** -0.5),
        'ffn2_norm': gain((L, D)),
        'ffn2_w_in': nrm((L, D, 2 * FFN_HIDDEN), D ** -0.5),
        'ffn2_w_out': nrm((L, FFN_HIDDEN, D), FFN_HIDDEN ** -0.5),
    }


def reference(x, rel_table, ffn1_norm, ffn1_w_in, ffn1_w_out, mix_norm, w_in, gate_bias, forget_bias,
              a_q_norm, a_k_norm, a_lambda, a_subln, c_q_norm, c_k_norm, d_q_norm, d_k_norm,
              w_branch, w_out, ffn2_norm, ffn2_w_in, ffn2_w_out):
    b, s, _ = x.shape
    in_idx = _offsets(IN_SPLITS)
    br_idx = _offsets(BRANCH_WIDTHS)
    for l in range(DEPTH):
        x = x + 0.5 * swiglu(rms_norm(x, ffn1_norm[l]), ffn1_w_in[l], ffn1_w_out[l])
        h = rms_norm(x, mix_norm[l])
        (aq, ak, av, bq, bk, bv, cq, ck, cv, cf, dq, dk, dv, gl) = jnp.split(h @ w_in[l], in_idx, axis=-1)
        lam_init = 0.8 - 0.6 * math.exp(-0.3 * l)
        oa = diff_attention(aq, ak, av, a_q_norm[l], a_k_norm[l], a_lambda[l], a_subln[l],
                            rel_table[:, :A_HEADS], lam_init)
        ob = stick_breaking_attention(bq, bk, bv)
        oc = forgetting_attention(cq, ck, cv, cf, forget_bias[l], c_q_norm[l], c_k_norm[l])
        od = dilated_attention(dq, dk, dv, d_q_norm[l], d_k_norm[l], rel_table[:, A_HEADS:])
        wa, wb, wc, wd = jnp.split(w_branch[l], br_idx, axis=0)
        gates = jax.nn.sigmoid(gl + gate_bias[l]).reshape(b, s, N_BRANCH, D_MODEL)
        merged = (gates[:, :, 0] * (oa @ wa) + gates[:, :, 1] * (ob @ wb)
                  + gates[:, :, 2] * (oc @ wc) + gates[:, :, 3] * (od @ wd))
        x = x + merged @ w_out[l]
        x = x + 0.5 * swiglu(rms_norm(x, ffn2_norm[l]), ffn2_w_in[l], ffn2_w_out[l])
    return x
```

```cpp
#include <hip/hip_runtime.h>
#include <hip/hip_cooperative_groups.h>
#include <cstdio>
#include <cstdint>
#include <cmath>
namespace cg = cooperative_groups;
namespace pg8 {
#define PG8_LAS __attribute__((address_space(3)))
typedef unsigned short bf16_t;
typedef short bf16x8 __attribute__((ext_vector_type(8)));
typedef float f32x4 __attribute__((ext_vector_type(4)));
typedef unsigned u32x4 __attribute__((ext_vector_type(4)));
constexpr int BM = 256, BK = 64, HALF = 128, HTB = HALF * BK * 2  , STAGE_BYTES = 8 * HTB, NXCD = 8, WGM = 8;

__host__ __device__ __forceinline__ int lds_byte(int r, int c) { const int st = (r >> 4) * 2 + (c >> 5), rr = r & 15, cc = c & 31, ob = rr * 64 + cc * 2; return st * 1024 + (ob ^ (((ob >> 9) & 1) << 5)); }
__host__ __device__ __forceinline__ void stage_rc(int b, int& R, int& C) { const int st = b / 1024, sb = b % 1024, swz = sb ^ (((sb >> 9) & 1) << 5); R = (st >> 1) * 16 + swz / 64; C = (st & 1) * 32 + (swz % 64) / 2; }
__host__ __device__ __forceinline__ int perm32(int rho) { const int n = rho >> 4, i = rho & 15; return 8 * (i >> 2) + 4 * n + (i & 3); }

struct Unit { int pm, pn; };
struct Gemm { const bf16_t* A; const bf16_t* Bt; int M, N, K; };

struct StaticOrder {
    int nM, nN, nwg, G, c;
    __host__ __device__ void init(int M, int N, int G_, int c_) { nM = M / BM; nN = N / BM; nwg = nM * nN; G = G_; c = c_; }
    __host__ __device__ bool next(int i, Unit& u) const {
        const long L = (long)i * G + c; if (L >= nwg) return false;
        int wgid = (int)L; { const int q = nwg / NXCD, r = nwg % NXCD, xcd = wgid % NXCD, off = wgid / NXCD; wgid = (xcd < r ? xcd * (q + 1) : r * (q + 1) + (xcd - r) * q) + off; }
        const int nig = WGM * nN, gid = wgid / nig, fm = gid * WGM, gsz = (nM - fm) < WGM ? (nM - fm) : WGM;
        u.pm = fm + ((wgid % nig) % gsz); u.pn = (wgid % nig) / gsz; return true;
    }
    __device__ __forceinline__ void a_ready(const Unit&) const {}
    __device__ __forceinline__ void done(const Unit&) const {}
};
__device__ __forceinline__ unsigned cvt_pk_bf16(float lo, float hi) { unsigned r; asm volatile("v_cvt_pk_bf16_f32 %0, %1, %2" : "=v"(r) : "v"(lo), "v"(hi)); return r; }
template <class Epi, class Sched, bool ALIGN_EPI = false, bool SP2 = false>
__device__ __forceinline__ void gemm_phase(PG8_LAS unsigned char* lds, const Gemm g, const Sched& S, const Epi& E) {
    int tid_ = threadIdx.x; asm volatile("" : "+v"(tid_));
    const int tid = tid_, wid = __builtin_amdgcn_readfirstlane(tid >> 6), lane = tid & 63, wr = wid >> 2, wc = wid & 3, fr = lane & 15, fq = lane >> 4;
    const int K = g.K, nt = K / BK;
    unsigned voffA, voffB;
    { int R, C; stage_rc(tid * 16, R, C); const int Rb = Epi::PERM ? ((R & ~31) + perm32(R & 31)) : R;
      voffA = (unsigned)(R * K + C) * 2u; voffB = (unsigned)(Rb * K + C) * 2u; }
    const size_t r64 = (size_t)64 * K * 2;
    const size_t kstep = (size_t)(BK * 2);
    const size_t hstep = (size_t)HALF * K * 2;
    const size_t tstep = 2 * hstep;
    const unsigned ldsw = (unsigned)wid * 1024u;
    const int aoff = lds_byte(wr * 64 + fr, fq * 8), boff = lds_byte(wc * 32 + fr, fq * 8);
#define PG8_SA(b, h) (((b) * 2 + (h)) * HTB)
#define PG8_SB(b, h) ((4 + (b) * 2 + (h)) * HTB)
#define PG8_STAGE(bufoff, gbase, voff) do { _Pragma("unroll") for (int _i = 0; _i < 2; ++_i) \
        __builtin_amdgcn_global_load_lds((const unsigned*)((const char*)(gbase) + (size_t)_i * r64 + (voff)), (PG8_LAS unsigned*)(lds + (bufoff) + ldsw + _i * 8192), 16, 0, 0); } while (0)
#define PG8_LDA(dst, b, h) do { _Pragma("unroll") for (int m = 0; m < 4; ++m) _Pragma("unroll") for (int k = 0; k < 2; ++k) dst[m][k] = *(const PG8_LAS bf16x8*)(lds + PG8_SA(b, h) + aoff + m * 2048 + k * 1024); } while (0)
#define PG8_LDB(dst, b, h) do { _Pragma("unroll") for (int n = 0; n < 2; ++n) _Pragma("unroll") for (int k = 0; k < 2; ++k) dst[n][k] = *(const PG8_LAS bf16x8*)(lds + PG8_SB(b, h) + boff + n * 2048 + k * 1024); } while (0)
#define PG8_MMA(ai, bj, At, Bt) do { __builtin_amdgcn_s_setprio(1); _Pragma("unroll") for (int m = 0; m < 4; ++m) _Pragma("unroll") for (int n = 0; n < 2; ++n) _Pragma("unroll") for (int k = 0; k < 2; ++k) \
        acc[ai][bj][m][n] = __builtin_amdgcn_mfma_f32_16x16x32_bf16(Bt[n][k], At[m][k], acc[ai][bj][m][n], 0, 0, 0); __builtin_amdgcn_s_setprio(0); } while (0)
#define PG8_WAIT_V(n) asm volatile("s_waitcnt vmcnt(" #n ")" ::: "memory")
#define PG8_WAIT_L(n) asm volatile("s_waitcnt lgkmcnt(" #n ")" ::: "memory")
#define PG8_BAR __builtin_amdgcn_s_barrier()
#define PG8_SCHED __builtin_amdgcn_sched_barrier(0)
    Unit cur, nxt; int ui = 0;
    if (!S.next(0, cur)) return;
    f32x4 acc[2][2][4][2];
#pragma unroll
    for (int a = 0; a < 2; ++a)
#pragma unroll
        for (int b = 0; b < 2; ++b)
#pragma unroll
            for (int m = 0; m < 4; ++m)
#pragma unroll
                for (int n = 0; n < 2; ++n) acc[a][b][m][n] = (f32x4){0.f, 0.f, 0.f, 0.f};
    bf16x8 At[4][2], B0[2][2], B1[2][2];
    const char* cA = (const char*)g.A + (size_t)cur.pm * tstep; const char* cB = (const char*)g.Bt + (size_t)cur.pn * tstep;
    S.a_ready(cur);
    if constexpr (SP2) {
        PG8_STAGE(PG8_SB(0, 0), cB, voffB); PG8_STAGE(PG8_SB(0, 1), cB + hstep, voffB); PG8_STAGE(PG8_SA(0, 0), cA, voffA); PG8_STAGE(PG8_SA(0, 1), cA + hstep, voffA);
        if (wr == 1) PG8_BAR;
        PG8_WAIT_V(2); PG8_BAR;
        PG8_STAGE(PG8_SB(1, 0), cB + kstep, voffB); PG8_STAGE(PG8_SA(1, 0), cA + kstep, voffA); PG8_STAGE(PG8_SB(1, 1), cB + hstep + kstep, voffB);
        PG8_WAIT_V(6); PG8_BAR;
    } else {
        PG8_STAGE(PG8_SB(0, 0), cB, voffB); PG8_STAGE(PG8_SA(0, 0), cA, voffA); PG8_STAGE(PG8_SB(0, 1), cB + hstep, voffB); PG8_STAGE(PG8_SA(0, 1), cA + hstep, voffA);
        if (wr == 1) PG8_BAR;
        PG8_WAIT_V(4); PG8_BAR;
        PG8_STAGE(PG8_SB(1, 0), cB + kstep, voffB); PG8_STAGE(PG8_SA(1, 0), cA + kstep, voffA); PG8_STAGE(PG8_SB(1, 1), cB + hstep + kstep, voffB);
        PG8_WAIT_V(6); PG8_BAR;
    }
    for (;;) {
        const bool has_next = S.next(ui + 1, nxt);
        const char* nA = has_next ? (const char*)g.A + (size_t)nxt.pm * tstep : cA; const char* nB = has_next ? (const char*)g.Bt + (size_t)nxt.pn * tstep : cB;
        for (int t = 0; t < nt; t += 2) {
            const bool last = (t == nt - 2);
            const char* a1 = cA + (size_t)(t + 1) * kstep;
            const char* a2 = last ? nA : cA + (size_t)(t + 2) * kstep; const char* b2 = last ? nB : cB + (size_t)(t + 2) * kstep;
            const char* a3 = a2 + kstep; const char* b3 = b2 + kstep;
            if (last && has_next) S.a_ready(nxt);
            if constexpr (SP2) {
            PG8_LDB(B0, 0, 0); PG8_LDB(B1, 0, 1); PG8_SCHED; PG8_LDA(At, 0, 0); PG8_STAGE(PG8_SA(1, 1), a1 + hstep, voffA);
            PG8_WAIT_V(8); PG8_WAIT_L(0); PG8_BAR; PG8_MMA(0, 0, At, B0); PG8_MMA(0, 1, At, B1); PG8_BAR; PG8_SCHED;
            PG8_LDA(At, 0, 1); PG8_STAGE(PG8_SB(0, 0), b2, voffB); PG8_STAGE(PG8_SB(0, 1), b2 + hstep, voffB); PG8_STAGE(PG8_SA(0, 0), a2, voffA);
            PG8_WAIT_V(8); PG8_WAIT_L(0); PG8_BAR; PG8_MMA(1, 0, At, B0); PG8_MMA(1, 1, At, B1); PG8_BAR; PG8_SCHED;
            PG8_LDB(B0, 1, 0); PG8_LDB(B1, 1, 1); PG8_SCHED; PG8_LDA(At, 1, 0); PG8_STAGE(PG8_SA(0, 1), a2 + hstep, voffA);
            PG8_WAIT_V(8); PG8_WAIT_L(0); PG8_BAR; PG8_MMA(0, 0, At, B0); PG8_MMA(0, 1, At, B1); PG8_BAR; PG8_SCHED;
            PG8_LDA(At, 1, 1); PG8_STAGE(PG8_SB(1, 0), b3, voffB); PG8_STAGE(PG8_SB(1, 1), b3 + hstep, voffB); PG8_STAGE(PG8_SA(1, 0), a3, voffA);
            PG8_WAIT_V(8); PG8_WAIT_L(0); PG8_BAR; PG8_MMA(1, 0, At, B0); PG8_MMA(1, 1, At, B1); PG8_BAR; PG8_SCHED;
            } else {
            PG8_LDB(B0, 0, 0); PG8_SCHED; PG8_LDA(At, 0, 0); PG8_STAGE(PG8_SA(1, 1), a1 + hstep, voffA);
            PG8_WAIT_L(8); PG8_BAR; PG8_WAIT_L(0); PG8_MMA(0, 0, At, B0); PG8_BAR; PG8_SCHED;
            PG8_LDB(B1, 0, 1); PG8_STAGE(PG8_SB(0, 0), b2, voffB);
            PG8_BAR; PG8_WAIT_L(0); PG8_MMA(0, 1, At, B1); PG8_BAR;
            PG8_LDA(At, 0, 1); PG8_STAGE(PG8_SA(0, 0), a2, voffA);
            PG8_BAR; PG8_WAIT_L(0); PG8_MMA(1, 0, At, B0); PG8_BAR; PG8_SCHED;
            PG8_STAGE(PG8_SB(0, 1), b2 + hstep, voffB);
            PG8_WAIT_V(6); PG8_BAR; PG8_MMA(1, 1, At, B1); PG8_BAR;
            PG8_LDB(B0, 1, 0); PG8_SCHED; PG8_LDA(At, 1, 0); PG8_STAGE(PG8_SA(0, 1), a2 + hstep, voffA);
            PG8_WAIT_L(8); PG8_BAR; PG8_WAIT_L(0); PG8_MMA(0, 0, At, B0); PG8_BAR; PG8_SCHED;
            PG8_LDB(B1, 1, 1); PG8_STAGE(PG8_SB(1, 0), b3, voffB);
            PG8_BAR; PG8_WAIT_L(0); PG8_MMA(0, 1, At, B1); PG8_BAR;
            PG8_LDA(At, 1, 1); PG8_STAGE(PG8_SA(1, 0), a3, voffA);
            PG8_BAR; PG8_WAIT_L(0); PG8_MMA(1, 0, At, B0); PG8_BAR; PG8_SCHED;
            PG8_STAGE(PG8_SB(1, 1), b3 + hstep, voffB);
            PG8_WAIT_V(6); PG8_BAR; PG8_MMA(1, 1, At, B1); PG8_BAR;
            }
        }
        if constexpr (ALIGN_EPI) { if (wr == 0) PG8_BAR; }
        if constexpr (!Epi::AFTER_DRAIN) { E(acc, cur, wr, wc, fr, fq); S.done(cur); }
        if (!has_next) break;
#pragma unroll
        for (int a = 0; a < 2; ++a)
#pragma unroll
            for (int b = 0; b < 2; ++b)
#pragma unroll
                for (int m = 0; m < 4; ++m)
#pragma unroll
                    for (int n = 0; n < 2; ++n) acc[a][b][m][n] = (f32x4){0.f, 0.f, 0.f, 0.f};
        cur = nxt; cA = nA; cB = nB; ++ui;
        if constexpr (ALIGN_EPI) { if (wr == 1) PG8_BAR; }
    }
    PG8_WAIT_V(0);
    if constexpr (!ALIGN_EPI) { if (wr == 0) PG8_BAR; }
    PG8_BAR;
    if constexpr (Epi::AFTER_DRAIN) { E.fused(acc, cur, wr, wc, fr, fq, lds, wid, lane); S.done(cur); }
#undef PG8_SA
#undef PG8_SB
#undef PG8_STAGE
#undef PG8_LDA
#undef PG8_LDB
#undef PG8_MMA
#undef PG8_WAIT_V
#undef PG8_WAIT_L
#undef PG8_BAR
#undef PG8_SCHED
}
}

#define GAS __attribute__((address_space(1)))
#define LAS __attribute__((address_space(3)))
typedef unsigned short bf16;
typedef unsigned v4u __attribute__((ext_vector_type(4)));
typedef unsigned v2u __attribute__((ext_vector_type(2)));
typedef float f32x4 __attribute__((ext_vector_type(4)));
typedef float f32x16 __attribute__((ext_vector_type(16)));
typedef short bf16x8 __attribute__((ext_vector_type(8)));
typedef __bf16 bf16x2_t __attribute__((ext_vector_type(2)));
typedef float f32x2_t __attribute__((ext_vector_type(2)));
#define LDS_WAIT() asm volatile("s_waitcnt lgkmcnt(0)" ::: "memory")
#define MFMA32(a, b, c) __builtin_amdgcn_mfma_f32_32x32x16_bf16((a), (b), (c), 0, 0, 0)

constexpr int M = 32768, D = 1024, S = 2048, NBATCH = 16, FF = 2816, DIN = 9094, NQKV = 5120;
constexpr float LOG2E = 1.4426950408889634f, LN2 = 0.6931471805599453f;
constexpr float QSCALE = 0.125f * LOG2E;
constexpr float RMS_EPS = 1e-6f;
constexpr size_t MiB = 1u << 20;
constexpr size_t WS_CTL = 0, WS_LOGF = 1 * MiB, WS_W = 2 * MiB, W_LAYER = 56 * MiB, WS_HN = 114 * MiB, WS_BIG = 178 * MiB, WS_RSP = 507 * MiB, WS_END = 509 * MiB;
constexpr size_t W_1T = 0, W_2T = 11 * MiB, W_INT = 16 * MiB + MiB / 2, W_GT = 26 * MiB + MiB / 2, W_BRT = 34 * MiB + MiB / 2, W_OT = 37 * MiB + MiB / 2,
                 W_3T = 39 * MiB + MiB / 2, W_4T = 50 * MiB + MiB / 2;
constexpr size_t WB_A = 0, WB_B = 1 * MiB, WB_C = 1 * MiB + 3 * MiB / 4, WB_D = 2 * MiB + MiB / 2;
constexpr size_t B_QA = 0, B_QB = 32 * MiB, B_QC = 56 * MiB, B_OD = 80 * MiB, B_KA = 96 * MiB, B_VA = 128 * MiB, B_KB = 160 * MiB, B_VB = 184 * MiB,
                 B_KC = 208 * MiB, B_VC = 232 * MiB, B_QD = 256 * MiB, B_KD = 280 * MiB, B_VD = 304 * MiB;
constexpr size_t B_P = 96 * MiB, B_TMP = 160 * MiB, B_MRG = 224 * MiB;
constexpr int LDS_BYTES = 156672, LDS_BST = 155648 + 64;
constexpr int NTHREADS = 512;

struct Params;
typedef const __attribute__((address_space(4))) Params* PPtr;
struct Params {
    const float* in[22];
    float* out;
    unsigned char* ws;
    float lam_init[2];
    float one_minus_lam_init[2];
};

__device__ __forceinline__ int opaque_tid() { int t = threadIdx.x; asm volatile("" : "+v"(t)); return t; }
__device__ __forceinline__ unsigned f2bf(float f) { unsigned u = __builtin_bit_cast(unsigned, f); return (u + 0x7fffu + ((u >> 16) & 1u)) >> 16; }
__device__ __forceinline__ unsigned pk2(float lo, float hi) { f32x2_t v = {lo, hi}; bf16x2_t b = __builtin_convertvector(v, bf16x2_t); return __builtin_bit_cast(unsigned, b); }
__device__ __forceinline__ float bflo(unsigned w) { return __builtin_bit_cast(float, w << 16); }
__device__ __forceinline__ float bfhi(unsigned w) { return __builtin_bit_cast(float, w & 0xffff0000u); }
__device__ __forceinline__ float fexp2(float x) { return __builtin_amdgcn_exp2f(x); }
__device__ __forceinline__ float flog2(float x) { return __builtin_amdgcn_logf(x); }
__device__ __forceinline__ float sigmoidf_(float x) { return __builtin_amdgcn_rcpf(1.0f + fexp2(-x * LOG2E)); }
__device__ __forceinline__ float row_rs(const float* rsp, int row) {
    const f32x4* q = (const f32x4*)(rsp + (size_t)row * 16);
    const f32x4 a = q[0], b = q[1], c = q[2], d = q[3];
    const float s = ((a[0] + a[1]) + (a[2] + a[3])) + ((b[0] + b[1]) + (b[2] + b[3])) + ((c[0] + c[1]) + (c[2] + c[3])) + ((d[0] + d[1]) + (d[2] + d[3]));
    return rsqrtf(s * (1.0f / 1024.0f) + 1e-6f);
}
__device__ __forceinline__ float wave_sum(float v) {
#pragma unroll
    for (int o = 1; o < 64; o <<= 1) v += __shfl_xor(v, o);
    return v;
}

typedef const pg8::f32x4 (&AccRef)[2][2][4][2];

struct EpiSwiglu {
    static constexpr bool PERM = true, AFTER_DRAIN = false;
    bf16* U; const LAS float* rst;
    __device__ __forceinline__ void operator()(AccRef acc, const pg8::Unit& u, int wr, int wc, int fr, int fq) const {
        const int row0 = u.pm * 256 + wr * 64 + fr, col0 = u.pn * 128 + wc * 32 + 8 * fq;
#pragma unroll
        for (int ai = 0; ai < 2; ++ai)
#pragma unroll
            for (int m = 0; m < 4; ++m) {
                const int row = row0 + ai * 128 + m * 16;
                const float rs = rst[row & 255];
                float v[8];
#pragma unroll
                for (int n = 0; n < 2; ++n)
#pragma unroll
                    for (int j = 0; j < 4; ++j) { const float g = acc[ai][0][m][n][j] * rs, up = acc[ai][1][m][n][j] * rs; v[4 * n + j] = g * sigmoidf_(g) * up; }
                v4u w; w.x = pk2(v[0], v[1]); w.y = pk2(v[2], v[3]); w.z = pk2(v[4], v[5]); w.w = pk2(v[6], v[7]);
                *(v4u*)(U + (size_t)row * FF + col0) = w;
            }
    }
};

struct EpiResid {
    static constexpr bool PERM = true, AFTER_DRAIN = false;
    bf16* xb; float* outf; float scale; float* rss;
    __device__ __forceinline__ void operator()(AccRef acc, const pg8::Unit& u, int wr, int wc, int fr, int fq) const {
        const int row0 = u.pm * 256 + wr * 64 + fr, col0 = u.pn * 256 + wc * 32 + 8 * fq;
#pragma unroll
        for (int ai = 0; ai < 2; ++ai) {
            v4u xw[4][2];
#pragma unroll
            for (int m = 0; m < 4; ++m)
#pragma unroll
                for (int bj = 0; bj < 2; ++bj) xw[m][bj] = *(const v4u*)(xb + (size_t)(row0 + ai * 128 + m * 16) * D + col0 + bj * 128);
#pragma unroll
            for (int m = 0; m < 4; ++m) {
                const int row = row0 + ai * 128 + m * 16;
                float ss = 0.f;
#pragma unroll
                for (int bj = 0; bj < 2; ++bj) {
                    const size_t p = (size_t)row * D + col0 + bj * 128;
                    const v4u w0 = xw[m][bj];
                    f32x4 a = {bflo(w0.x), bfhi(w0.x), bflo(w0.y), bfhi(w0.y)}, b = {bflo(w0.z), bfhi(w0.z), bflo(w0.w), bfhi(w0.w)};
                    a = a + acc[ai][bj][m][0] * scale; b = b + acc[ai][bj][m][1] * scale;
                    if (outf) { *(f32x4*)(outf + p) = a; *(f32x4*)(outf + p + 4) = b; }
                    else {
                        ss += (a[0] * a[0] + a[1] * a[1]) + (a[2] * a[2] + a[3] * a[3]) + (b[0] * b[0] + b[1] * b[1]) + (b[2] * b[2] + b[3] * b[3]);
                        v4u w; w.x = pk2(a[0], a[1]); w.y = pk2(a[2], a[3]); w.z = pk2(b[0], b[1]); w.w = pk2(b[2], b[3]);
                        *(v4u*)(xb + p) = w;
                    }
                }
                if (!outf) {
                    ss += __shfl_xor(ss, 16); ss += __shfl_xor(ss, 32);
                    if (fq == 0) rss[(size_t)row * 16 + u.pn * 4 + wc] = ss;
                }
            }
        }
    }
};

struct EpiQKV {
    static constexpr bool PERM = true, AFTER_DRAIN = false;
    unsigned char* big; const float *aq, *ak, *cq, *ck, *dq, *dk, *fb; float* logf; const LAS float* rst;
    __device__ __forceinline__ void operator()(AccRef acc, const pg8::Unit& u, int wr, int wc, int fr, int fq) const {
        const int G = u.pn * 4 + wc;
        if (G >= 79) return;
        const int row0 = u.pm * 256 + wr * 64 + fr;
        if (G == 78) {
            if (fq == 0) {
#pragma unroll
                for (int ai = 0; ai < 2; ++ai)
#pragma unroll
                    for (int m = 0; m < 4; ++m) {
                        const int row = row0 + ai * 128 + m * 16;
                        const float rsr = rst[row & 255];
#pragma unroll
                        for (int e = 0; e < 6; ++e) {
                            const float x = acc[ai][0][m][e >> 2][e & 3] * rsr + fb[e];
                            const float ls = fminf(x, 0.f) - LN2 * flog2(1.0f + fexp2(-fabsf(x) * LOG2E));
                            logf[(size_t)row * 8 + e] = ls;
                        }
                    }
            }
            return;
        }
        size_t off; int pitch, lg; const float* gain = nullptr; float sc = 1.f;
        if (G < 8)       { off = B_QA; pitch = 512; lg = G;      gain = aq; sc = QSCALE; }
        else if (G < 16) { off = B_KA; pitch = 512; lg = G - 8;  gain = ak; }
        else if (G < 24) { off = B_VA; pitch = 512; lg = G - 16; }
        else if (G < 30) { off = B_QB; pitch = 384; lg = G - 24; sc = QSCALE; }
        else if (G < 36) { off = B_KB; pitch = 384; lg = G - 30; }
        else if (G < 42) { off = B_VB; pitch = 384; lg = G - 36; }
        else if (G < 48) { off = B_QC; pitch = 384; lg = G - 42; gain = cq; sc = QSCALE; }
        else if (G < 54) { off = B_KC; pitch = 384; lg = G - 48; gain = ck; }
        else if (G < 60) { off = B_VC; pitch = 384; lg = G - 54; }
        else if (G < 66) { off = B_QD; pitch = 384; lg = G - 60; gain = dq; sc = QSCALE; }
        else if (G < 72) { off = B_KD; pitch = 384; lg = G - 66; gain = dk; }
        else             { off = B_VD; pitch = 384; lg = G - 72; }
        bf16* dst = (bf16*)(big + off) + lg * 64 + 8 * fq;
        f32x4 gv[2][2];
#pragma unroll
        for (int bj = 0; bj < 2; ++bj)
#pragma unroll
            for (int n = 0; n < 2; ++n) {
                f32x4 g4 = {1.f, 1.f, 1.f, 1.f};
                if (gain) g4 = *(const f32x4*)(gain + 32 * bj + 8 * fq + 4 * n);
                gv[bj][n] = g4 * sc;
            }
#pragma unroll
        for (int ai = 0; ai < 2; ++ai)
#pragma unroll
            for (int m = 0; m < 4; ++m) {
                const int row = row0 + ai * 128 + m * 16;
                const float rsr = rst[row & 255];
                f32x4 xv[2][2];
#pragma unroll
                for (int bj = 0; bj < 2; ++bj)
#pragma unroll
                    for (int n = 0; n < 2; ++n) xv[bj][n] = acc[ai][bj][m][n] * rsr;
                float rs = 1.f;
                if (gain) {
                    float ss = 0.f;
#pragma unroll
                    for (int bj = 0; bj < 2; ++bj)
#pragma unroll
                        for (int n = 0; n < 2; ++n) { const f32x4 x = xv[bj][n]; ss += (x[0] * x[0] + x[1] * x[1]) + (x[2] * x[2] + x[3] * x[3]); }
                    ss += __shfl_xor(ss, 16); ss += __shfl_xor(ss, 32);
                    rs = rsqrtf(ss * (1.0f / 64.0f) + RMS_EPS);
                }
#pragma unroll
                for (int bj = 0; bj < 2; ++bj) {
                    const f32x4 v0 = xv[bj][0] * rs * gv[bj][0], v1 = xv[bj][1] * rs * gv[bj][1];
                    v4u w; w.x = pk2(v0[0], v0[1]); w.y = pk2(v0[2], v0[3]); w.z = pk2(v1[0], v1[1]); w.w = pk2(v1[2], v1[3]);
                    *(v4u*)(dst + (size_t)row * pitch + 32 * bj) = w;
                }
            }
    }
};

struct EpiPStore {
    static constexpr bool PERM = true, AFTER_DRAIN = false;
    v4u* P;
    __device__ __forceinline__ void operator()(AccRef acc, const pg8::Unit& u, int wr, int wc, int fr, int fq) const {
        v4u* base = P + (size_t)(u.pm * 4 + u.pn) * 16 * NTHREADS + opaque_tid();
#pragma unroll
        for (int ai = 0; ai < 2; ++ai)
#pragma unroll
            for (int bj = 0; bj < 2; ++bj)
#pragma unroll
                for (int m = 0; m < 4; ++m) {
                    const f32x4 v0 = acc[ai][bj][m][0], v1 = acc[ai][bj][m][1];
                    v4u w; w.x = pk2(v0[0], v0[1]); w.y = pk2(v0[2], v0[3]); w.z = pk2(v1[0], v1[1]); w.w = pk2(v1[2], v1[3]);
                    base[(size_t)((ai * 2 + bj) * 4 + m) * NTHREADS] = w;
                    }
    }
};

struct EpiGate {
    static constexpr bool PERM = true, AFTER_DRAIN = false;
    const float* gb; const v4u* P; v4u* TMP; bf16* MRG; int first, last; const LAS float* rst;
    __device__ __forceinline__ void operator()(AccRef acc, const pg8::Unit& u, int wr, int wc, int fr, int fq) const {
        const size_t ub = (size_t)(u.pm * 4 + u.pn) * 16 * NTHREADS + opaque_tid();
        const int row0 = u.pm * 256 + wr * 64 + fr, col0 = u.pn * 256 + wc * 32 + 8 * fq;
#pragma unroll
        for (int bj = 0; bj < 2; ++bj) {
            const f32x4 bv0 = *(const f32x4*)(gb + col0 + bj * 128), bv1 = *(const f32x4*)(gb + col0 + bj * 128 + 4);
#pragma unroll
            for (int ai = 0; ai < 2; ++ai) {
                v4u pw4[4], tw4[4];
#pragma unroll
                for (int m = 0; m < 4; ++m) {
                    const size_t ci = ub + (size_t)((ai * 2 + bj) * 4 + m) * NTHREADS;
                    pw4[m] = P[ci];
                    if (!first) tw4[m] = TMP[ci]; else tw4[m] = (v4u){0u, 0u, 0u, 0u};
                }
#pragma unroll
                for (int m = 0; m < 4; ++m) {
                    const size_t ci = ub + (size_t)((ai * 2 + bj) * 4 + m) * NTHREADS;
                    const v4u pw = pw4[m], tw = tw4[m];
                    const float rs = rst[(row0 + ai * 128 + m * 16) & 255];
                    float v[8];
                    v[0] = sigmoidf_(acc[ai][bj][m][0][0] * rs + bv0[0]) * bflo(pw.x); v[1] = sigmoidf_(acc[ai][bj][m][0][1] * rs + bv0[1]) * bfhi(pw.x);
                    v[2] = sigmoidf_(acc[ai][bj][m][0][2] * rs + bv0[2]) * bflo(pw.y); v[3] = sigmoidf_(acc[ai][bj][m][0][3] * rs + bv0[3]) * bfhi(pw.y);
                    v[4] = sigmoidf_(acc[ai][bj][m][1][0] * rs + bv1[0]) * bflo(pw.z); v[5] = sigmoidf_(acc[ai][bj][m][1][1] * rs + bv1[1]) * bfhi(pw.z);
                    v[6] = sigmoidf_(acc[ai][bj][m][1][2] * rs + bv1[2]) * bflo(pw.w); v[7] = sigmoidf_(acc[ai][bj][m][1][3] * rs + bv1[3]) * bfhi(pw.w);
                    v[0] += bflo(tw.x); v[1] += bfhi(tw.x); v[2] += bflo(tw.y); v[3] += bfhi(tw.y);
                    v[4] += bflo(tw.z); v[5] += bfhi(tw.z); v[6] += bflo(tw.w); v[7] += bfhi(tw.w);
                    v4u w; w.x = pk2(v[0], v[1]); w.y = pk2(v[2], v[3]); w.z = pk2(v[4], v[5]); w.w = pk2(v[6], v[7]);
                    if (!last) TMP[ci] = w;
                    else *(v4u*)(MRG + (size_t)(row0 + ai * 128 + m * 16) * D + col0 + bj * 128) = w;
                }
            }
        }
    }
};

__device__ __forceinline__ void tr_item(const float* src, int ldw, int k0, int n0, bf16* dst, int ldt, int drow0, int dk0, LAS float* scr, int lane, const float* gk = nullptr) {
#pragma unroll 8
    for (int i = 0; i < 32; ++i) { const int kk = 2 * i + (lane >> 5); scr[kk * 33 + (lane & 31)] = src[(size_t)(k0 + kk) * ldw + n0 + (lane & 31)]; }
    LDS_WAIT(); asm volatile("" ::: "memory");
    const int c = lane & 7;
    f32x4 g0 = {1.f, 1.f, 1.f, 1.f}, g1 = g0;
    if (gk) { g0 = *(const f32x4*)(gk + k0 + 8 * c); g1 = *(const f32x4*)(gk + k0 + 8 * c + 4); }
#pragma unroll
    for (int j = 0; j < 4; ++j) {
        const int n = (lane >> 3) + 8 * j; const LAS float* sp = scr + (8 * c) * 33 + n;
        v4u o; o.x = pk2(sp[0 * 33] * g0[0], sp[1 * 33] * g0[1]); o.y = pk2(sp[2 * 33] * g0[2], sp[3 * 33] * g0[3]);
        o.z = pk2(sp[4 * 33] * g1[0], sp[5 * 33] * g1[1]); o.w = pk2(sp[6 * 33] * g1[2], sp[7 * 33] * g1[3]);
        *(v4u*)(dst + (size_t)(drow0 + n) * ldt + dk0 + 8 * c) = o;
    }
    LDS_WAIT(); asm volatile("" ::: "memory");
}

constexpr int NJ1 = 2816, NJ2 = 1408, NJ3 = 2496, NJ4 = 2048, NJ5A = 256, NJ5B = 192, NJ5C = 192, NJ5D = 64, NJ6 = 512;
constexpr int NPL = NJ1 + NJ2 + NJ3 + NJ4 + NJ5A + NJ5B + NJ5C + NJ5D + NJ6 + NJ1 + NJ2;

__device__ __forceinline__ void ffn_in_item(const float* w, bf16* dst, int r, LAS float* scr, int lane, const float* gk) {
    const int kb = r / 176, nb = r % 176, c0 = 32 * nb;
    const int drow = (c0 < FF) ? 256 * (c0 / 128) + (c0 % 128) : 256 * ((c0 - FF) / 128) + 128 + ((c0 - FF) % 128);
    tr_item(w, 2 * FF, 64 * kb, c0, dst, D, drow, 64 * kb, scr, lane, gk);
}
__device__ __forceinline__ void plain_item(const float* w, int ldw, int krow0, bf16* dst, int ldt, int r, LAS float* scr, int lane) {
    const int kb = r >> 5, nb = r & 31;
    tr_item(w, ldw, krow0 + 64 * kb, 32 * nb, dst, ldt, 32 * nb, 64 * kb, scr, lane);
}

__device__ __forceinline__ void prologue_weights(const Params& p, LAS unsigned char* lds) {
    const int tid = threadIdx.x, lane = tid & 63, wave = tid >> 6;
    LAS float* scr = (LAS float*)(lds + wave * 16384);
    const int gw = blockIdx.x * 8 + wave, NGW = gridDim.x * 8;
    for (int it = gw; it < 2 * NPL; it += NGW) {
        const int l = it / NPL; int r = it % NPL;
        unsigned char* wb = p.ws + WS_W + (size_t)l * W_LAYER;
        if (r < NJ1) { ffn_in_item(p.in[3] + (size_t)l * D * 2 * FF, (bf16*)(wb + W_1T), r, scr, lane, p.in[2] + (size_t)l * D); continue; } r -= NJ1;
        if (r < NJ2) { plain_item(p.in[4] + (size_t)l * FF * D, D, 0, (bf16*)(wb + W_2T), FF, r, scr, lane); continue; } r -= NJ2;
        if (r < NJ3) {
            const int kb = r / 156, nb = r % 156, L0 = 32 * nb, n0 = (L0 < 3840) ? L0 : L0 + 6;
            const int drow = 256 * (L0 >> 8) + 128 * ((L0 & 63) >> 5) + 32 * ((L0 >> 6) & 3);
            tr_item(p.in[6] + (size_t)l * D * DIN, DIN, 64 * kb, n0, (bf16*)(wb + W_INT), D, drow, 64 * kb, scr, lane, p.in[5] + (size_t)l * D); continue; } r -= NJ3;
        if (r < NJ4) {
            const int kb = r >> 7, nb = r & 127;
            tr_item(p.in[6] + (size_t)l * D * DIN, DIN, 64 * kb, 4998 + 32 * nb, (bf16*)(wb + W_GT), D, 32 * nb, 64 * kb, scr, lane, p.in[5] + (size_t)l * D); continue; } r -= NJ4;
        const float* wbr = p.in[17] + (size_t)l * 1408 * D;
        if (r < NJ5A) { plain_item(wbr, D, 0, (bf16*)(wb + W_BRT + WB_A), 512, r, scr, lane); continue; } r -= NJ5A;
        if (r < NJ5B) { plain_item(wbr, D, 512, (bf16*)(wb + W_BRT + WB_B), 384, r, scr, lane); continue; } r -= NJ5B;
        if (r < NJ5C) { plain_item(wbr, D, 896, (bf16*)(wb + W_BRT + WB_C), 384, r, scr, lane); continue; } r -= NJ5C;
        if (r < NJ5D) { plain_item(wbr, D, 1280, (bf16*)(wb + W_BRT + WB_D), 256, r, scr, lane); continue; } r -= NJ5D;
        if (r < NJ6) { plain_item(p.in[18] + (size_t)l * D * D, D, 0, (bf16*)(wb + W_OT), D, r, scr, lane); continue; } r -= NJ6;
        if (r < NJ1) { ffn_in_item(p.in[20] + (size_t)l * D * 2 * FF, (bf16*)(wb + W_3T), r, scr, lane, p.in[19] + (size_t)l * D); continue; } r -= NJ1;
        plain_item(p.in[21] + (size_t)l * FF * D, D, 0, (bf16*)(wb + W_4T), FF, r, scr, lane);
    }
    const int gt = blockIdx.x * NTHREADS + tid, NGT = gridDim.x * NTHREADS;
    for (int i = gt; i < 2 * 131072; i += NGT) {
        const int l = i >> 17, q = i & 131071;
        unsigned char* wb = p.ws + WS_W + (size_t)l * W_LAYER;
        { const int idx = q >> 10, k = q & 1023, R = 4864 + (idx >> 6) * 128 + 64 + (idx & 63), e = R - 4928;
          float v = 0.f; if (e >= 0 && e < 6) v = p.in[6][(size_t)l * D * DIN + (size_t)k * DIN + 3840 + e] * p.in[5][(size_t)l * D + k];
          ((bf16*)(wb + W_INT))[(size_t)R * D + k] = (bf16)f2bf(v); }
        { const int row = q >> 7, col = 128 + (q & 127); ((bf16*)(wb + W_BRT + WB_D))[(size_t)row * 256 + col] = 0; }
    }
}

__device__ __forceinline__ void norm_phase(const float* x, bf16* hn, float* rss) {
    const int tid = opaque_tid(), lane = tid & 63, wave = tid >> 6;
    const int gw = blockIdx.x * 8 + wave, NGW = gridDim.x * 8;
    for (int row = gw; row < M; row += NGW) {
        const f32x4* xr = (const f32x4*)(x + (size_t)row * D) + lane;
        f32x4 v[4]; float sq = 0.f;
#pragma unroll
        for (int j = 0; j < 4; ++j) { v[j] = xr[64 * j]; sq += (v[j][0] * v[j][0] + v[j][1] * v[j][1]) + (v[j][2] * v[j][2] + v[j][3] * v[j][3]); }
        sq = wave_sum(sq);
        if (lane < 16) rss[(size_t)row * 16 + lane] = (lane == 0) ? sq : 0.f;
        v2u* o8 = (v2u*)(hn + (size_t)row * D) + lane;
#pragma unroll
        for (int j = 0; j < 4; ++j) { v2u w; w.x = pk2(v[j][0], v[j][1]); w.y = pk2(v[j][2], v[j][3]); o8[64 * j] = w; }
    }
}

constexpr int KPITCH = 72;
constexpr int AL_KS0 = 0, AL_KS1 = 9216, AL_VT0 = 36864, AL_VT1 = 54272, AL_LUT = 73728, AL_CB = 75776, AL_SCAN = 83968, AL_ITEM = 84032, AL_O0 = 86016;
constexpr float NEG_BIG = -1.0e4f;

template <int DV> struct TileRegs { v4u k; v4u v[DV / 64]; };

template <int DV> __device__ __forceinline__ void tile_load(TileRegs<DV>& R, const bf16* Kp, int kpitch, const bf16* Vp, int vpitch, int k0, int tid) {
    const int key = tid >> 3, c = tid & 7;
    R.k = *(const v4u*)(Kp + (unsigned)((k0 + key) * kpitch + 8 * c));
#pragma unroll
    for (int i = 0; i < DV / 64; ++i) R.v[i] = *(const v4u*)(Vp + (unsigned)((k0 + key) * vpitch + 64 * i + 8 * c));
}
template <int DV> __device__ __forceinline__ void tile_store(const TileRegs<DV>& R, LAS unsigned char* ks, LAS unsigned char* vt, int tid) {
    const int key = tid >> 3, c = tid & 7;
    *(LAS v4u*)(ks + (key * KPITCH + 8 * c) * 2) = R.k;
#pragma unroll
    for (int i = 0; i < DV / 64; ++i) *(LAS v4u*)(vt + (key * (DV + 8) + 64 * i + 8 * c) * 2) = R.v[i];
}
__device__ __forceinline__ bf16x8 pack8(const f32x16& s, int st) {
    v4u w;
    if (st == 0) { w.x = pk2(s[0], s[1]); w.y = pk2(s[2], s[3]); w.z = pk2(s[4], s[5]); w.w = pk2(s[6], s[7]); }
    else         { w.x = pk2(s[8], s[9]); w.y = pk2(s[10], s[11]); w.z = pk2(s[12], s[13]); w.w = pk2(s[14], s[15]); }
    return __builtin_bit_cast(bf16x8, w);
}
typedef short v4i16_t __attribute__((ext_vector_type(4)));
template <int DV> __device__ __forceinline__ bf16x8 vfrag(LAS unsigned char* vt, int dv0, int kbase, int lane) {
    const int i16 = lane & 15, q = i16 >> 2, pp_ = i16 & 3, blk = (lane >> 4) & 1;
    LAS unsigned char* p0 = vt + ((kbase + q) * (DV + 8) + dv0 + 16 * blk + 4 * pp_) * 2;
    const v4i16_t lo = __builtin_amdgcn_ds_read_tr16_b64_v4i16((LAS v4i16_t*)p0);
    const v4i16_t hi = __builtin_amdgcn_ds_read_tr16_b64_v4i16((LAS v4i16_t*)(p0 + 8 * (DV + 8) * 2));
    return __builtin_shufflevector(lo, hi, 0, 1, 2, 3, 4, 5, 6, 7);
}
__device__ __forceinline__ int rel_bucket(int n) {
    if (n < 16) return n;
    return 16 + (n >= 19) + (n >= 21) + (n >= 24) + (n >= 27) + (n >= 31) + (n >= 35) + (n >= 40) + (n >= 46) + (n >= 52) + (n >= 59) + (n >= 67) + (n >= 77) + (n >= 87) + (n >= 99) + (n >= 113);
}

template <int KIND>
__device__ __forceinline__ void softmax_tile(f32x16& s0, f32x16& s1, float& l, int t, int k0, int h, int qlo, const LAS float* lut, const LAS float* cb, int W, int dmask, float rowshift) {
    const float NINF = -__builtin_inff();
    if (KIND == 0) {
        if (k0 + 63 + 128 <= qlo) {
            const float c = lut[128];
#pragma unroll
            for (int i = 0; i < 16; ++i) { s0[i] += c; s1[i] += c; }
        } else {
#pragma unroll
            for (int i = 0; i < 16; ++i) {
                const int j0 = k0 + (i & 3) + 8 * (i >> 2) + 4 * h, n0 = t - j0, n1 = n0 - 32;
                const float b0 = lut[min(max(n0, 0), 128)], b1 = lut[min(max(n1, 0), 128)];
                s0[i] = (n0 >= 0) ? s0[i] + b0 : NINF; s1[i] = (n1 >= 0) ? s1[i] + b1 : NINF;
            }
        }
    } else if (KIND == 1) {
        const bool diag = (k0 + 63 > qlo);
#pragma unroll
        for (int c = 0; c < 4; ++c) {
            const f32x4 b0 = *(const LAS f32x4*)(cb + k0 + 8 * c + 4 * h), b1 = *(const LAS f32x4*)(cb + k0 + 32 + 8 * c + 4 * h);
#pragma unroll
            for (int jj = 0; jj < 4; ++jj) {
                const int i = 4 * c + jj; const int n0 = t - (k0 + 8 * c + 4 * h + jj), n1 = n0 - 32;
                float x0 = s0[i] + (b0[jj] + rowshift), x1 = s1[i] + (b1[jj] + rowshift);
                if (diag) { x0 = (n0 >= 0) ? x0 : NINF; x1 = (n1 >= 0) ? x1 : NINF; }
                s0[i] = x0; s1[i] = x1;
            }
        }
    } else {
#pragma unroll
        for (int i = 0; i < 16; ++i) {
            const int j0 = k0 + (i & 3) + 8 * (i >> 2) + 4 * h, n0 = t - j0, n1 = n0 - 32;
            const float b0 = lut[min(max(n0, 0), 128)], b1 = lut[min(max(n1, 0), 128)];
            const bool v0 = (n0 >= 0) && (n0 <= W) && ((n0 & dmask) == 0), v1 = (n1 >= 0) && (n1 <= W) && ((n1 & dmask) == 0);
            s0[i] = v0 ? s0[i] + b0 : NINF; s1[i] = v1 ? s1[i] + b1 : NINF;
        }
    }
    float ps = 0.f;
#pragma unroll
    for (int i = 0; i < 16; ++i) { s0[i] = fexp2(s0[i]); s1[i] = fexp2(s1[i]); ps += s0[i] + s1[i]; }
    l += ps;
}

__device__ __forceinline__ void stick_block(f32x16& s, float& Rr, int t, int kbase, int h, bool diag) {
    float u[16], gs[4], pg[4];
#pragma unroll
    for (int i = 0; i < 16; ++i) {
        const float z = s[i];
        const float sp = fmaxf(z, 0.f) + flog2(1.0f + fexp2(-fabsf(z)));
        const int j = kbase + (i & 3) + 8 * (i >> 2) + 4 * h;
        const bool valid = !diag || (j < t);
        u[i] = valid ? -sp : 0.f;
        s[i] = valid ? (z - sp) : -__builtin_inff();
    }
#pragma unroll
    for (int c = 0; c < 4; ++c) { gs[c] = (u[4 * c] + u[4 * c + 1]) + (u[4 * c + 2] + u[4 * c + 3]); pg[c] = __shfl_xor(gs[c], 32); }
    float run = Rr;
#pragma unroll
    for (int c = 3; c >= 0; --c) {
        float tl = run + ((h == 0) ? pg[c] : 0.f);
#pragma unroll
        for (int jj = 3; jj >= 0; --jj) { const int i = 4 * c + jj; const float a = fexp2(s[i] + tl); tl += u[i]; s[i] = a; }
        run += gs[c] + pg[c];
    }
    Rr = run;
}

template <int KIND  , int DV>
__device__ __forceinline__ void attn_pass(LAS unsigned char* L, const bf16* Qp, int qpitch, const bf16* Kp, int kpitch, const bf16* Vp, int vpitch,
                                          int q0w, int t_lo, int t_hi, f32x16 (&o)[DV / 32], const float bnd, float& l, float& Rr,
                                          const LAS float* lut, const LAS float* cb, int W, int dmask, const int tid, const bool wave_on = true) {
    const int lane = tid & 63, r = lane & 31, h = lane >> 5;
    const int t = q0w + r, qlo = q0w, qhi = wave_on ? q0w + 31 : -1;
    bf16x8 qf[4];
#pragma unroll
    for (int ks = 0; ks < 4; ++ks) qf[ks] = *(const bf16x8*)(Qp + (unsigned)((wave_on ? t : 0) * qpitch + 16 * ks + 8 * h));
    TileRegs<DV> TA, TB;
    __syncthreads();
    tile_load<DV>(TA, Kp, kpitch, Vp, vpitch, t_hi * 64, tid);
    tile_store<DV>(TA, L + AL_KS0, L + AL_VT0, tid);
    if (t_hi - 1 >= t_lo) tile_load<DV>(TA, Kp, kpitch, Vp, vpitch, (t_hi - 1) * 64, tid);
    float rowshift = 0.f;
    if (KIND == 1) rowshift = -cb[t] - bnd;
    int buf = 0;
#define ATTN_STEP(TCUR, TNXT)                                                                                                          \
    {                                                                                                                                   \
        __syncthreads();                                                                                                                \
        if (tt - 2 >= t_lo) tile_load<DV>(TNXT, Kp, kpitch, Vp, vpitch, (tt - 2) * 64, tid);                                            \
        const int k0 = tt * 64;                                                                                                         \
        bool active = (k0 <= qhi);                                                                                                      \
        if (KIND == 2) active = active && (k0 + 63 >= qlo - W);                                                                         \
        if (active) {                                                                                                                   \
            LAS unsigned char* ks = L + (buf ? AL_KS1 : AL_KS0);                                                                        \
            LAS unsigned char* vt = L + (buf ? AL_VT1 : AL_VT0);                                                                        \
            f32x16 s0, s1;                                                                                                              \
            _Pragma("unroll") for (int i = 0; i < 16; ++i) { s0[i] = 0.f; s1[i] = 0.f; }                                                \
            _Pragma("unroll") for (int kk = 0; kk < 4; ++kk) {                                                                          \
                const bf16x8 a0 = *(const LAS bf16x8*)(ks + (r * KPITCH + 16 * kk + 8 * h) * 2);                                        \
                const bf16x8 a1 = *(const LAS bf16x8*)(ks + ((32 + r) * KPITCH + 16 * kk + 8 * h) * 2);                                 \
                s0 = MFMA32(a0, qf[kk], s0); s1 = MFMA32(a1, qf[kk], s1);                                                               \
            }                                                                                                                           \
            if (KIND == 3) {                                                                                                            \
                const bool diag = (k0 + 63 >= qlo);                                                                                     \
                stick_block(s1, Rr, t, k0 + 32, h, diag);                                                                               \
                stick_block(s0, Rr, t, k0, h, diag);                                                                                    \
            } else {                                                                                                                    \
                softmax_tile<KIND>(s0, s1, l, t, k0, h, qlo, lut, cb, W, dmask, rowshift);                                              \
            }                                                                                                                           \
            _Pragma("unroll") for (int st = 0; st < 2; ++st) {                                                                          \
                const bf16x8 pb = pack8(s0, st);                                                                                        \
                _Pragma("unroll") for (int db = 0; db < DV / 32; ++db) o[db] = MFMA32(vfrag<DV>(vt, 32 * db, 16 * st + 4 * h, lane), pb, o[db]);      \
            }                                                                                                                           \
            _Pragma("unroll") for (int st = 0; st < 2; ++st) {                                                                          \
                const bf16x8 pb = pack8(s1, st);                                                                                        \
                _Pragma("unroll") for (int db = 0; db < DV / 32; ++db) o[db] = MFMA32(vfrag<DV>(vt, 32 * db, 32 + 16 * st + 4 * h, lane), pb, o[db]); \
            }                                                                                                                           \
        }                                                                                                                               \
        if (tt - 1 >= t_lo) tile_store<DV>(TCUR, L + (buf ? AL_KS0 : AL_KS1), L + (buf ? AL_VT0 : AL_VT1), tid);                        \
        buf ^= 1;                                                                                                                       \
    }
    for (int tt = t_hi; tt >= t_lo; tt -= 2) {
        ATTN_STEP(TA, TB)
        if (tt - 1 < t_lo) break;
        { const int tt_save = tt; (void)tt_save; }
        tt -= 1;
        ATTN_STEP(TB, TA)
        tt += 1;
    }
#undef ATTN_STEP
}

__device__ __forceinline__ void qk_tile(LAS unsigned char* ks, const bf16x8 (&qf)[4], int r, int h, f32x16& s0, f32x16& s1) {
    bf16x8 kf[8];
#pragma unroll
    for (int kk = 0; kk < 4; ++kk) {
        kf[2 * kk]     = *(const LAS bf16x8*)(ks + (r * KPITCH + 16 * kk + 8 * h) * 2);
        kf[2 * kk + 1] = *(const LAS bf16x8*)(ks + ((32 + r) * KPITCH + 16 * kk + 8 * h) * 2);
    }
#pragma unroll
    for (int i = 0; i < 16; ++i) { s0[i] = 0.f; s1[i] = 0.f; }
#pragma unroll
    for (int kk = 0; kk < 4; ++kk) { s0 = MFMA32(kf[2 * kk], qf[kk], s0); s1 = MFMA32(kf[2 * kk + 1], qf[kk], s1); }
}
__device__ __forceinline__ void pv_tile(LAS unsigned char* vt, const f32x16& s0, const f32x16& s1, int h, int lane, f32x16 (&o)[2]) {
#pragma unroll
    for (int st = 0; st < 2; ++st) {
        const bf16x8 pb = pack8(s0, st);
#pragma unroll
        for (int db = 0; db < 2; ++db) o[db] = MFMA32(vfrag<64>(vt, 32 * db, 16 * st + 4 * h, lane), pb, o[db]);
    }
#pragma unroll
    for (int st = 0; st < 2; ++st) {
        const bf16x8 pb = pack8(s1, st);
#pragma unroll
        for (int db = 0; db < 2; ++db) o[db] = MFMA32(vfrag<64>(vt, 32 * db, 32 + 16 * st + 4 * h, lane), pb, o[db]);
    }
}
template <int KIND  >
__device__ __forceinline__ void score_tile(f32x16& s0, f32x16& s1, float& l, float& Rr, int t, int k0, int h, int qlo, const LAS float* lut, const LAS float* cb, int W, int dmask, float rowshift) {
    if (KIND == 3) { const bool diag = (k0 + 63 >= qlo); stick_block(s1, Rr, t, k0 + 32, h, diag); stick_block(s0, Rr, t, k0, h, diag); }
    else softmax_tile<KIND>(s0, s1, l, t, k0, h, qlo, lut, cb, W, dmask, rowshift);
}

template <int KIND  >
__device__ __forceinline__ void attn_pass2(LAS unsigned char* L, const bf16* Qp, int qpitch, const bf16* Kp, int kpitch, const bf16* Vp, int vpitch,
                                           int q0w, int t_lo, int t_hi, f32x16 (&o)[2], const float bnd, float& l, float& Rr,
                                           const LAS float* lut, const LAS float* cb, int W, int dmask, const int tid, const bool wave_on = true) {
    const int lane = tid & 63, r = lane & 31, h = lane >> 5;
    const int t = q0w + r, qlo = q0w, qhi = wave_on ? q0w + 31 : -1;
    bf16x8 qf[4];
#pragma unroll
    for (int ks = 0; ks < 4; ++ks) qf[ks] = *(const bf16x8*)(Qp + (unsigned)((wave_on ? t : 0) * qpitch + 16 * ks + 8 * h));
    TileRegs<64> TA, TB;
    __syncthreads();
    tile_load<64>(TA, Kp, kpitch, Vp, vpitch, t_hi * 64, tid);
    if (t_hi - 1 >= t_lo) tile_load<64>(TB, Kp, kpitch, Vp, vpitch, (t_hi - 1) * 64, tid);
    tile_store<64>(TA, L + 0, L + 36864, tid);
    if (t_hi - 1 >= t_lo) tile_store<64>(TB, L + 9216, L + 36864 + 9216, tid);
    if (t_hi - 2 >= t_lo) tile_load<64>(TA, Kp, kpitch, Vp, vpitch, (t_hi - 2) * 64, tid);
    if (t_hi - 3 >= t_lo) tile_load<64>(TB, Kp, kpitch, Vp, vpitch, (t_hi - 3) * 64, tid);
    float rowshift = 0.f;
    if (KIND == 1) rowshift = -cb[t] - bnd;
    int par = 0;
    for (int tt = t_hi; tt >= t_lo; tt -= 2) {
        __syncthreads();
        const int k0a = tt * 64, k0b = k0a - 64;
        bool actA = (k0a <= qhi), actB = (tt - 1 >= t_lo) && (k0b <= qhi);
        if (KIND == 2) { actA = actA && (k0a + 63 >= qlo - W); actB = actB && (k0b + 63 >= qlo - W); }
        LAS unsigned char* ksA = L + par * 9216;       LAS unsigned char* vtA = L + 36864 + par * 9216;
        LAS unsigned char* ksB = L + (par + 1) * 9216; LAS unsigned char* vtB = L + 36864 + (par + 1) * 9216;
        if (actA && actB) {
            f32x16 a0, a1, b0, b1;
            qk_tile(ksA, qf, r, h, a0, a1);
            qk_tile(ksB, qf, r, h, b0, b1);
            score_tile<KIND>(a0, a1, l, Rr, t, k0a, h, qlo, lut, cb, W, dmask, rowshift);
            pv_tile(vtA, a0, a1, h, lane, o);
            score_tile<KIND>(b0, b1, l, Rr, t, k0b, h, qlo, lut, cb, W, dmask, rowshift);
            pv_tile(vtB, b0, b1, h, lane, o);
        } else if (actA) {
            f32x16 a0, a1;
            qk_tile(ksA, qf, r, h, a0, a1);
            score_tile<KIND>(a0, a1, l, Rr, t, k0a, h, qlo, lut, cb, W, dmask, rowshift);
            pv_tile(vtA, a0, a1, h, lane, o);
        } else if (actB) {
            f32x16 b0, b1;
            qk_tile(ksB, qf, r, h, b0, b1);
            score_tile<KIND>(b0, b1, l, Rr, t, k0b, h, qlo, lut, cb, W, dmask, rowshift);
            pv_tile(vtB, b0, b1, h, lane, o);
        }
        const int np = par ^ 2;
        if (tt - 2 >= t_lo) tile_store<64>(TA, L + np * 9216, L + 36864 + np * 9216, tid);
        if (tt - 3 >= t_lo) tile_store<64>(TB, L + (np + 1) * 9216, L + 36864 + (np + 1) * 9216, tid);
        if (tt - 4 >= t_lo) tile_load<64>(TA, Kp, kpitch, Vp, vpitch, (tt - 4) * 64, tid);
        if (tt - 5 >= t_lo) tile_load<64>(TB, Kp, kpitch, Vp, vpitch, (tt - 5) * 64, tid);
        par = np;
    }
}

template <int NB> __device__ __forceinline__ void zero_o(f32x16 (&o)[NB]) {
#pragma unroll
    for (int b = 0; b < NB; ++b)
#pragma unroll
        for (int i = 0; i < 16; ++i) o[b][i] = 0.f;
}
__device__ __forceinline__ void store_o64(const f32x16 (&o)[2], float inv, bf16* orow, int h) {
#pragma unroll
    for (int db = 0; db < 2; ++db)
#pragma unroll
        for (int c = 0; c < 4; ++c) {
            v2u w; w.x = pk2(o[db][4 * c] * inv, o[db][4 * c + 1] * inv); w.y = pk2(o[db][4 * c + 2] * inv, o[db][4 * c + 3] * inv);
            *(v2u*)(orow + 32 * db + 8 * c + 4 * h) = w;
        }
}

constexpr int N_ABC_ITEMS = 8 * 256, N_ATT_ITEMS = N_ABC_ITEMS + 512;
constexpr size_t DP_O = 0, DP_L = (size_t)48 << 20;

__device__ __forceinline__ void attention_phase(PPtr p, int layer, LAS unsigned char* L, unsigned* counter, const bool do_store) {
    const int tid = opaque_tid(), lane = tid & 63, wave = tid >> 6, r = lane & 31, h = lane >> 5;
    unsigned char* big = p->ws + WS_BIG;
    LAS float* lut = (LAS float*)(L + AL_LUT);
    LAS float* cb = (LAS float*)(L + AL_CB);
    LAS float* scan = (LAS float*)(L + AL_SCAN);
    volatile LAS unsigned* itemw = (volatile LAS unsigned*)(L + AL_ITEM);
    const float* rel = p->in[1];
    for (;;) {
        __syncthreads();
        if (tid == 0) itemw[0] = atomicAdd(counter, 1u);
        __syncthreads();
        const int idx = (int)itemw[0];
        if (idx >= N_ATT_ITEMS) break;
        int tl_ = tid; asm volatile("" : "+v"(tl_));
        const int lane = tl_ & 63, r = lane & 31, h = lane >> 5;
        int qb, rr, dsel = 0;
        if (idx < N_ABC_ITEMS) { qb = 7 - (idx >> 8); rr = idx & 255; }
        else { dsel = idx - N_ABC_ITEMS; qb = 0; rr = 256; }
#ifdef PROBE_ATT_TYPE
        if (!do_store) { const int ty = (rr < 64) ? 0 : (rr < 160 ? 1 : (rr < 256 ? 2 : 3)); if (ty != PROBE_ATT_TYPE) continue; }
#endif
        const int q0blk = qb * 256, q0w = q0blk + 32 * wave;
        const int t_hi = (q0blk + 255) >> 6;
        float dummyR = 0.f;
        if (rr < 64) {
            const int b = rr >> 2, hd = rr & 3;
            float bnd;
            {
                float mq = fabsf(p->in[9][layer * 64 + lane]), mk = fabsf(p->in[10][layer * 64 + lane]), mb = (lane < 32) ? fabsf(rel[lane * 10 + hd]) : 0.f;
#pragma unroll
                for (int o_ = 1; o_ < 64; o_ <<= 1) { mq = fmaxf(mq, __shfl_xor(mq, o_)); mk = fmaxf(mk, __shfl_xor(mk, o_)); mb = fmaxf(mb, __shfl_xor(mb, o_)); }
                bnd = 64.f * mq * mk * QSCALE * 1.02f + mb * LOG2E + 0.5f;
            }
            if (tid <= 128) lut[tid] = rel[rel_bucket(tid) * 10 + hd] * LOG2E - bnd;
            const float* lv = p->in[11] + (size_t)layer * 256;
            const float lam = expf(wave_sum(lv[lane] * lv[64 + lane])) - expf(wave_sum(lv[128 + lane] * lv[192 + lane])) + p->lam_init[layer];
            const size_t rowb = (size_t)b * S;
            bf16* QA = (bf16*)(big + B_QA) + rowb * 512 + hd * 128;
            const bf16* KA = (const bf16*)(big + B_KA) + rowb * 512 + hd * 128;
            const bf16* VA = (const bf16*)(big + B_VA) + rowb * 512 + hd * 128;
            LAS unsigned* o0p = (LAS unsigned*)(L + AL_O0) + tid;
            f32x16 o[4]; float l;
            zero_o<4>(o); l = 0.f;
            attn_pass<0, 128>(L, QA, 512, KA, 512, VA, 512, q0w, 0, t_hi, o, bnd, l, dummyR, lut, cb, 0, 0, tid);
            { const float inv = 1.0f / (l + __shfl_xor(l, 32));
#pragma unroll
              for (int db = 0; db < 4; ++db)
#pragma unroll
                  for (int i = 0; i < 8; ++i) o0p[(db * 8 + i) * NTHREADS] = pk2(o[db][2 * i] * inv, o[db][2 * i + 1] * inv); }
            zero_o<4>(o); l = 0.f;
            attn_pass<0, 128>(L, QA + 64, 512, KA + 64, 512, VA, 512, q0w, 0, t_hi, o, bnd, l, dummyR, lut, cb, 0, 0, tid);
            { const float inv = lam / (l + __shfl_xor(l, 32));
              float ss = 0.f;
#pragma unroll
              for (int db = 0; db < 4; ++db)
#pragma unroll
                  for (int i = 0; i < 8; ++i) {
                      const unsigned w0 = o0p[(db * 8 + i) * NTHREADS];
                      const float a = bflo(w0) - o[db][2 * i] * inv, c = bfhi(w0) - o[db][2 * i + 1] * inv;
                      o[db][2 * i] = a; o[db][2 * i + 1] = c; ss += a * a + c * c;
                  }
              ss += __shfl_xor(ss, 32);
              const float rs = rsqrtf(ss * (1.0f / 128.0f) + RMS_EPS) * p->one_minus_lam_init[layer];
              const float* sg = p->in[12] + (size_t)layer * 128;
              bf16* orow = QA + (size_t)(q0w + r) * 512;
              if (do_store)
#pragma unroll
              for (int db = 0; db < 4; ++db)
#pragma unroll
                  for (int c = 0; c < 4; ++c) {
                      const int dv = 32 * db + 8 * c + 4 * h;
                      const f32x4 g4 = *(const f32x4*)(sg + dv);
                      v2u w; w.x = pk2(o[db][4 * c] * rs * g4[0], o[db][4 * c + 1] * rs * g4[1]); w.y = pk2(o[db][4 * c + 2] * rs * g4[2], o[db][4 * c + 3] * rs * g4[3]);
                      *(v2u*)(orow + dv) = w;
                  }
            }
        } else if (rr < 160) {
            const int q = rr - 64, b = q / 6, hd = q % 6;
            const size_t rowb = (size_t)b * S;
            bf16* QB = (bf16*)(big + B_QB) + rowb * 384 + hd * 64;
            const bf16* KB = (const bf16*)(big + B_KB) + rowb * 384 + hd * 64;
            const bf16* VB = (const bf16*)(big + B_VB) + rowb * 384 + hd * 64;
            f32x16 o[2]; float l = 0.f, Rr = 0.f;
            zero_o<2>(o);
            attn_pass2<3>(L, QB, 384, KB, 384, VB, 384, q0w, 0, t_hi, o, 0.f, l, Rr, lut, cb, 0, 0, tid);
            if (do_store) store_o64(o, 1.0f, QB + (size_t)(q0w + r) * 384, h);
        } else if (rr < 256) {
            const int q = rr - 160, b = q / 6, hd = q % 6;
            const size_t rowb = (size_t)b * S;
            {
                const int qend = q0blk + 256;
                const float* lf = (const float*)(p->ws + WS_LOGF) + rowb * 8 + hd;
                int tq = tid; asm volatile("" : "+v"(tq));
                float v[4];
#pragma unroll
                for (int i = 0; i < 4; ++i) { const int tok = 4 * tq + i; v[i] = (tok < qend) ? lf[(size_t)tok * 8] : 0.f; }
                v[1] += v[0]; v[2] += v[1]; v[3] += v[2];
                float incl = v[3];
#pragma unroll
                for (int off = 1; off < 64; off <<= 1) { const float y = __shfl_up(incl, off); if (lane >= off) incl += y; }
                if (lane == 63) scan[wave] = incl;
                __syncthreads();
                float pre = incl - v[3];
                for (int w2 = 0; w2 < wave; ++w2) pre += scan[w2];
#pragma unroll
                for (int i = 0; i < 4; ++i) cb[4 * tid + i] = -(pre + v[i]) * LOG2E;
            }
            bf16* QC = (bf16*)(big + B_QC) + rowb * 384 + hd * 64;
            const bf16* KC = (const bf16*)(big + B_KC) + rowb * 384 + hd * 64;
            const bf16* VC = (const bf16*)(big + B_VC) + rowb * 384 + hd * 64;
            float bnd;
            {   float mq = fabsf(p->in[13][layer * 64 + lane]), mk = fabsf(p->in[14][layer * 64 + lane]);
#pragma unroll
                for (int o_ = 1; o_ < 64; o_ <<= 1) { mq = fmaxf(mq, __shfl_xor(mq, o_)); mk = fmaxf(mk, __shfl_xor(mk, o_)); }
                bnd = 64.f * mq * mk * QSCALE * 1.02f + 0.5f; }
            f32x16 o[2]; float l = 0.f;
            zero_o<2>(o);
            attn_pass2<1>(L, QC, 384, KC, 384, VC, 384, q0w, 0, t_hi, o, bnd, l, dummyR, lut, cb, 0, 0, tid);
            const float inv = 1.0f / (l + __shfl_xor(l, 32));
            if (do_store) store_o64(o, inv, QC + (size_t)(q0w + r) * 384, h);
        } else {
            int g, dd, bh, rsel, npass;
            if (dsel < 256)      { g = 0; dd = 1;  bh = dsel & 31; rsel = 7 - (dsel >> 5); npass = 1; }
            else if (dsel < 384) { const int j = dsel - 256; g = 1; dd = 4;  bh = j & 31; rsel = j >> 5; npass = 2; }
            else                 { const int j = dsel - 384; g = 2; dd = 16; bh = j & 31; rsel = j >> 5; npass = 4; }
            const int b = bh >> 1, hs = bh & 1, Sv = S / dd;
            const size_t rowb = (size_t)b * S;
            float bnd;
            {   float mq = fabsf(p->in[15][layer * 64 + lane]), mk = fabsf(p->in[16][layer * 64 + lane]);
                float mb = (lane < 32) ? fmaxf(fmaxf(fabsf(rel[lane * 10 + 4 + hs]), fabsf(rel[lane * 10 + 6 + hs])), fabsf(rel[lane * 10 + 8 + hs])) : 0.f;
#pragma unroll
                for (int o_ = 1; o_ < 64; o_ <<= 1) { mq = fmaxf(mq, __shfl_xor(mq, o_)); mk = fmaxf(mk, __shfl_xor(mk, o_)); mb = fmaxf(mb, __shfl_xor(mb, o_)); }
                bnd = 64.f * mq * mk * QSCALE * 1.02f + mb * LOG2E + 0.5f; }
            if (tid <= 128) lut[tid] = rel[rel_bucket(min(dd * tid, 2047)) * 10 + 4 + 2 * g + hs] * LOG2E - bnd;
            const int col = (2 * g + hs) * 64;
#pragma unroll 1
            for (int pi = 0; pi < npass; ++pi) {
                const int rho = (g == 0) ? 0 : (g == 1 ? rsel : rsel + 4 * pi);
                const int q0v = (g == 0) ? rsel * 256 : (g == 1 ? (1 - pi) * 256 : 0);
                const bf16* QD = (const bf16*)(big + B_QD) + (rowb + rho) * 384 + col;
                const bf16* KD = (const bf16*)(big + B_KD) + (rowb + rho) * 384 + col;
                const bf16* VD = (const bf16*)(big + B_VD) + (rowb + rho) * 384 + col;
                const int q0wv = q0v + 32 * wave;
                const bool won = q0wv < Sv;
                const int thv = (min(q0v + 255, Sv - 1)) >> 6, tlv = max(0, q0v - 128) >> 6;
                f32x16 o[2]; float l = 0.f;
                zero_o<2>(o);
                attn_pass<2, 64>(L, QD, 384 * dd, KD, 384 * dd, VD, 384 * dd, q0wv, tlv, thv, o, bnd, l, dummyR, lut, cb, 128, 0, tid, won);
                const float lt = l + __shfl_xor(l, 32);
                if (won && do_store) {
                    const size_t tok = rowb + rho + (size_t)dd * (q0wv + r);
                    float* po = (float*)((unsigned char*)p->out + DP_O) + ((size_t)g * M + tok) * 128 + hs * 64;
#pragma unroll
                    for (int db = 0; db < 2; ++db)
#pragma unroll
                        for (int c = 0; c < 4; ++c) *(f32x4*)(po + 32 * db + 8 * c + 4 * h) = (f32x4){o[db][4 * c], o[db][4 * c + 1], o[db][4 * c + 2], o[db][4 * c + 3]};
                    if (h == 0) ((float*)((unsigned char*)p->out + DP_L))[((size_t)g * M + tok) * 2 + hs] = lt;
                }
            }
        }
    }
}

__device__ __forceinline__ void dcombine_phase(float* dout, bf16* od) {
    const int tid = opaque_tid();
    const float* PO = (const float*)((unsigned char*)dout + DP_O); const float* PL = (const float*)((unsigned char*)dout + DP_L);
    for (int u = blockIdx.x * NTHREADS + tid; u < M * 32; u += gridDim.x * NTHREADS) {
        const int tok = u >> 5, c0 = (u & 31) * 8;
        v4u w = {0u, 0u, 0u, 0u};
        if (c0 < 128) {
            const int hs = c0 >> 6;
            f32x4 a = {0.f, 0.f, 0.f, 0.f}, bq = a; float lsum = 0.f;
#pragma unroll
            for (int g = 0; g < 3; ++g) {
                const float* q = PO + ((size_t)g * M + tok) * 128 + c0;
                a = a + *(const f32x4*)q; bq = bq + *(const f32x4*)(q + 4);
                lsum += PL[((size_t)g * M + tok) * 2 + hs];
            }
            const float inv = 1.0f / lsum;
            w.x = pk2(a[0] * inv, a[1] * inv); w.y = pk2(a[2] * inv, a[3] * inv); w.z = pk2(bq[0] * inv, bq[1] * inv); w.w = pk2(bq[2] * inv, bq[3] * inv);
        }
        *(v4u*)(od + (size_t)tok * 256 + c0) = w;
    }
}

#define XB_TMO      128
#define XB_XCNT(j)  (256  + 64 * (j))
#define XB_XSUB(j)  (1280 + 64 * (j))
#define XB_XGEN(j)  (2304 + 64 * (j))
#define XB_TOP      3328
#define XB_TOPGEN   3392
#define XCD_BAR_WORDS 3456
#define XB_SPIN_CAP (1u << 18)

__device__ __forceinline__ unsigned xb_ld(unsigned* p)              { return __hip_atomic_load(p, __ATOMIC_RELAXED, __HIP_MEMORY_SCOPE_AGENT); }
__device__ __forceinline__ unsigned xb_add(unsigned* p, unsigned v) { return __hip_atomic_fetch_add(p, v, __ATOMIC_RELAXED, __HIP_MEMORY_SCOPE_AGENT); }
__device__ __forceinline__ unsigned xb_xcc_id() { return (unsigned)__builtin_amdgcn_s_getreg((3 << 11) | 20) & 0xFu; }
#define XB_SPIN(cond, bar) do { unsigned _sp = 0; while (cond) { __builtin_amdgcn_s_sleep(1); \
    if ((++_sp & 255u) == 0u) { if (xb_ld(&(bar)[XB_TMO])) break; if (_sp > XB_SPIN_CAP) { atomicAdd(&(bar)[XB_TMO], 1u); break; } } } } while (0)

struct XcdBarrier {
    unsigned* bar; unsigned x;
    volatile LAS unsigned* st;
};

__device__ __forceinline__ XcdBarrier xcd_barrier_post(unsigned* bar, volatile LAS unsigned* st) {
    XcdBarrier b; b.bar = bar; b.x = xb_xcc_id(); b.st = st;
    if (threadIdx.x == 0) (void)xb_add(&bar[XB_XCNT(b.x)], 1u);
    return b;
}
__device__ __forceinline__ void xcd_barrier_complete(unsigned* bar, unsigned x, unsigned& nloc, unsigned& nx) {
    const unsigned G = gridDim.x * gridDim.y * gridDim.z;
    unsigned sum, cnt, mine, sp = 0u;
    for (;;) {
        sum = 0u; cnt = 0u; mine = 0u;
#pragma unroll
        for (unsigned j = 0; j < 16; ++j) { const unsigned c = xb_ld(&bar[XB_XCNT(j)]); sum += c; cnt += (c > 0u) ? 1u : 0u; mine = (j == x) ? c : mine; }
        if (sum == G) break;
        __builtin_amdgcn_s_sleep(1);
        if ((++sp & 255u) == 0u) { if (xb_ld(&bar[XB_TMO])) break; if (sp > XB_SPIN_CAP) { atomicAdd(&bar[XB_TMO], 1u); break; } }
    }
    nloc = mine > 0u ? mine : 1u; nx = cnt > 0u ? cnt : 1u;
}

__device__ __forceinline__ void xcd_barrier(const XcdBarrier& b) {
    asm volatile("s_waitcnt vmcnt(0)" ::: "memory");
    __syncthreads();
    if (threadIdx.x == 0) {
        unsigned* bar = b.bar;
        __builtin_amdgcn_s_waitcnt(0);
        unsigned nloc = b.st[0], nx = b.st[1];
        if (nloc == 0u) { xcd_barrier_complete(bar, b.x, nloc, nx); b.st[0] = nloc; b.st[1] = nx; }
        const unsigned old = xb_add(&bar[XB_XSUB(b.x)], 1u);
        const unsigned gen = old / nloc;
        if (old + 1u == (gen + 1u) * nloc) {
            __builtin_amdgcn_fence(__ATOMIC_RELEASE, "agent");
            asm volatile("s_waitcnt vmcnt(0)" ::: "memory");
            const unsigned og = xb_add(&bar[XB_TOP], 1u);
            const unsigned tg = og / nx;
            if (og + 1u == (tg + 1u) * nx) xb_add(&bar[XB_TOPGEN], 1u);
            else XB_SPIN(xb_ld(&bar[XB_TOPGEN]) == tg, bar);
            __builtin_amdgcn_fence(__ATOMIC_ACQUIRE, "agent");
            xb_add(&bar[XB_XGEN(b.x)], 1u);
            asm volatile("s_waitcnt vmcnt(0)" ::: "memory");
        } else {
            XB_SPIN(xb_ld(&bar[XB_XGEN(b.x)]) == gen, bar);
            __builtin_amdgcn_fence(__ATOMIC_ACQUIRE, "agent");
            asm volatile("s_waitcnt vmcnt(0)" ::: "memory");
        }
    }
    __syncthreads();
}

struct EpiAny {
    static constexpr bool PERM = true, AFTER_DRAIN = false;
    PPtr pp; LAS unsigned char* lds; int kind, layer, bi; float* outf; float scale; const float* rss_in; float* rss_out;
    __device__ __forceinline__ void operator()(AccRef acc, const pg8::Unit& u, int wr, int wc, int fr, int fq) const {
        asm volatile("" : "+v"(fr), "+v"(fq));
        unsigned char* ws = pp->ws; unsigned char* big = ws + WS_BIG;
        LAS float* rst = (LAS float*)(lds + 131072 + 256);
        if (kind == 0 || kind == 2 || kind == 4) {
            const int t = opaque_tid();
            if (t < 256) rst[t] = row_rs(rss_in, u.pm * 256 + t);
            __syncthreads();
        }
        if (kind == 0) { EpiSwiglu E{(bf16*)big, rst}; E(acc, u, wr, wc, fr, fq); }
        else if (kind == 1) { EpiResid E{(bf16*)(ws + WS_HN), outf, scale, rss_out}; E(acc, u, wr, wc, fr, fq); }
        else if (kind == 2) {
            const int l = layer;
            EpiQKV E{big, pp->in[9] + l * 64, pp->in[10] + l * 64, pp->in[13] + l * 64, pp->in[14] + l * 64, pp->in[15] + l * 64, pp->in[16] + l * 64, pp->in[8] + l * 6, (float*)(ws + WS_LOGF), rst};
            E(acc, u, wr, wc, fr, fq);
        }
        else if (kind == 3) { EpiPStore E{(v4u*)(big + B_P)}; E(acc, u, wr, wc, fr, fq); }
        else { EpiGate E{pp->in[7] + (size_t)layer * 4 * D + (size_t)bi * D, (const v4u*)(big + B_P), (v4u*)(big + B_TMP), (bf16*)(big + B_MRG), bi == 0, bi == 3, rst}; E(acc, u, wr, wc, fr, fq); }
    }
};

constexpr int STEPS_PER_LAYER = 16, CW_BAR = 4096;
#ifndef PROBE_STEP
#define PROBE_STEP (-1)
#endif
#ifndef PROBE_SYNCS
#define PROBE_SYNCS 0
#endif
__global__ void __launch_bounds__(NTHREADS, 2) mega_fwd(Params p) {
    extern __shared__ __attribute__((aligned(16))) unsigned char lds_raw[];
    LAS unsigned char* lds = (LAS unsigned char*)lds_raw;
    cg::grid_group grid = cg::this_grid();

    if (blockIdx.x == 0) for (int i = threadIdx.x; i < CW_BAR + XCD_BAR_WORDS; i += NTHREADS) ((unsigned*)(p.ws + WS_CTL))[i] = 0u;
    volatile LAS unsigned* bst = (volatile LAS unsigned*)(lds + LDS_BST);
    if (threadIdx.x < 2) bst[threadIdx.x] = 0u;
    prologue_weights(p, lds);
#ifdef PROBE_PROLOGUE
    prologue_weights(p, lds);
#endif
    norm_phase(p.in[0], (bf16*)(p.ws + WS_HN), (float*)(p.ws + WS_RSP));
    grid.sync();
    (void)xcd_barrier_post((unsigned*)(p.ws + WS_CTL) + CW_BAR, bst);

    constexpr int SPL = STEPS_PER_LAYER + ((PROBE_STEP >= 0) ? 1 : 0);
#pragma unroll 1
    for (int step = 0; step < 2 * SPL; ++step) {
        const int l = step / SPL; int k = step % SPL; bool dry = false;
        if (PROBE_STEP >= 0) { if (k == PROBE_STEP) dry = true; else if (k > PROBE_STEP) k -= 1; }
        PPtr pp = (PPtr)__builtin_amdgcn_kernarg_segment_ptr(); asm volatile("" : "+s"(pp));
        unsigned char* ws = pp->ws;
        unsigned char* wb = ws + WS_W + (size_t)l * W_LAYER;
        unsigned char* big = ws + WS_BIG;
        bf16* HN = (bf16*)(ws + WS_HN);
        float* xres = pp->out;
        float* rssb = (float*)(ws + WS_RSP);
        bool is_att = false, is_comb = false, sync_after = true;
        const bf16* A = HN; const bf16* Bt = (const bf16*)wb; int N = D, K = D;
        EpiAny E; E.pp = pp; E.lds = lds; E.kind = 1; E.layer = l; E.bi = 0; E.outf = nullptr; E.scale = 1.0f; E.rss_in = rssb; E.rss_out = rssb;
        if (k == 0)       { A = HN; Bt = (const bf16*)(wb + W_1T); N = 2 * FF; K = D; E.kind = 0; E.rss_in = rssb; }
        else if (k == 1)  { A = (const bf16*)big; Bt = (const bf16*)(wb + W_2T); N = D; K = FF; E.kind = 1; E.scale = 0.5f; }
        else if (k == 2)  { A = HN; Bt = (const bf16*)(wb + W_INT); N = NQKV; K = D; E.kind = 2; E.rss_in = rssb; }
        else if (k == 3)  { is_att = true; }
        else if (k == 4)  { is_comb = true; }
        else if (k < 13)  {
            const int i = (k - 5) >> 1;
            E.bi = i;
            if (((k - 5) & 1) == 0) {
                const size_t aoff = (i == 0) ? B_QA : (i == 1 ? B_QB : (i == 2 ? B_QC : B_OD));
                const size_t woff = (i == 0) ? WB_A : (i == 1 ? WB_B : (i == 2 ? WB_C : WB_D));
                A = (const bf16*)(big + aoff); Bt = (const bf16*)(wb + W_BRT + woff); N = D; K = (i == 0) ? 512 : (i == 3 ? 256 : 384); E.kind = 3;
            } else {
                A = HN; Bt = (const bf16*)(wb + W_GT) + (size_t)i * D * D; N = D; K = D; E.kind = 4; E.rss_in = rssb;
            }
            sync_after = (k == 12);
        }
        else if (k == 13) { A = (const bf16*)(big + B_MRG); Bt = (const bf16*)(wb + W_OT); N = D; K = D; E.kind = 1; E.scale = 1.0f; }
        else if (k == 14) { A = HN; Bt = (const bf16*)(wb + W_3T); N = 2 * FF; K = D; E.kind = 0; E.rss_in = rssb; }
        else              { A = (const bf16*)big; Bt = (const bf16*)(wb + W_4T); N = D; K = FF; E.kind = 1; E.scale = 0.5f; if (l == 1) E.outf = xres; }

        if (is_comb) {
            dcombine_phase(xres, (bf16*)(big + B_OD));
        } else if (!is_att) {
            if (dry && E.kind == 1) { E.scale = 0.f; E.outf = nullptr; }
            pg8::Gemm g{A, Bt, M, N, K}; pg8::StaticOrder So; So.init(M, N, (int)gridDim.x, (int)blockIdx.x);
            pg8::gemm_phase<EpiAny, pg8::StaticOrder, true, true>(lds, g, So, E);
        } else {
            attention_phase(pp, l, lds, (unsigned*)(ws + WS_CTL) + l + (dry ? 2 : 0), !dry);
        }
        if (step == 2 * SPL - 1) sync_after = false;
        if (dry || sync_after) {
            XcdBarrier xb; xb.bar = (unsigned*)(ws + WS_CTL) + CW_BAR; xb.x = xb_xcc_id(); xb.st = (volatile LAS unsigned*)(lds + LDS_BST);
            int nb = 1;
            if (PROBE_SYNCS > 0 && k == 0) nb += PROBE_SYNCS;
#pragma unroll 1
            for (int i = 0; i < nb; ++i) xcd_barrier(xb);
        }
    }
}

extern "C" void kernel_launch(void* const* d_in, const int* in_sizes, int n_in, void* d_out, int out_size, void* d_ws, size_t ws_size, hipStream_t stream) {
    static int grid = 0;
    if (grid == 0) {
        if (n_in != 22 || out_size != M * D || ws_size < WS_END) { fprintf(stderr, "kernel_launch: unexpected shapes (n_in %d, out %d, ws %zu)\n", n_in, out_size, ws_size); grid = -1; return; }
        int dev = 0, cus = 0, per_cu = 0;
        hipGetDevice(&dev);
        hipDeviceGetAttribute(&cus, hipDeviceAttributeMultiprocessorCount, dev);
        if (hipFuncSetAttribute((const void*)mega_fwd, hipFuncAttributeMaxDynamicSharedMemorySize, LDS_BYTES) != hipSuccess) fprintf(stderr, "kernel_launch: hipFuncSetAttribute failed\n");
        if (hipOccupancyMaxActiveBlocksPerMultiprocessor(&per_cu, (const void*)mega_fwd, NTHREADS, LDS_BYTES) != hipSuccess || per_cu < 1) per_cu = 1;
        (void)hipGetLastError();
        grid = cus * per_cu;
    }
    if (grid < 0) return;
    Params p{};
    for (int i = 0; i < 22; ++i) p.in[i] = (const float*)d_in[i];
    p.out = (float*)d_out; p.ws = (unsigned char*)d_ws;
    for (int l = 0; l < 2; ++l) { const double li = 0.8 - 0.6 * exp(-0.3 * (double)l); p.lam_init[l] = (float)li; p.one_minus_lam_init[l] = (float)(1.0 - li); }
    void* args[] = {&p};
    hipError_t e = hipLaunchCooperativeKernel((const void*)mega_fwd, dim3(grid), dim3(NTHREADS), args, LDS_BYTES, stream);
    if (e != hipSuccess) fprintf(stderr, "cooperative launch failed: %s (grid %d)\n", hipGetErrorString(e), grid);
}
```

```cpp
#include <hip/hip_runtime.h>
#include <hip/hip_cooperative_groups.h>
#include <cstdio>
#include <cstdint>
#include <cmath>
namespace cg = cooperative_groups;
namespace pg8 {
#define PG8_LAS __attribute__((address_space(3)))
typedef unsigned short bf16_t;
typedef short bf16x8 __attribute__((ext_vector_type(8)));
typedef float f32x4 __attribute__((ext_vector_type(4)));
typedef unsigned u32x4 __attribute__((ext_vector_type(4)));
constexpr int BM = 256, BK = 64, HALF = 128, HTB = HALF * BK * 2  , STAGE_BYTES = 8 * HTB, NXCD = 8, WGM = 8;

__host__ __device__ __forceinline__ int lds_byte(int r, int c) { const int st = (r >> 4) * 2 + (c >> 5), rr = r & 15, cc = c & 31, ob = rr * 64 + cc * 2; return st * 1024 + (ob ^ (((ob >> 9) & 1) << 5)); }
__host__ __device__ __forceinline__ void stage_rc(int b, int& R, int& C) { const int st = b / 1024, sb = b % 1024, swz = sb ^ (((sb >> 9) & 1) << 5); R = (st >> 1) * 16 + swz / 64; C = (st & 1) * 32 + (swz % 64) / 2; }
__host__ __device__ __forceinline__ int perm32(int rho) { const int n = rho >> 4, i = rho & 15; return 8 * (i >> 2) + 4 * n + (i & 3); }

struct Unit { int pm, pn; };
struct Gemm { const bf16_t* A; const bf16_t* Bt; int M, N, K; };

struct StaticOrder {
    int nM, nN, nwg, G, c;
    __host__ __device__ void init(int M, int N, int G_, int c_) { nM = M / BM; nN = N / BM; nwg = nM * nN; G = G_; c = c_; }
    __host__ __device__ bool next(int i, Unit& u) const {
        const long L = (long)i * G + c; if (L >= nwg) return false;
        int wgid = (int)L; { const int q = nwg / NXCD, r = nwg % NXCD, xcd = wgid % NXCD, off = wgid / NXCD; wgid = (xcd < r ? xcd * (q + 1) : r * (q + 1) + (xcd - r) * q) + off; }
        const int nig = WGM * nN, gid = wgid / nig, fm = gid * WGM, gsz = (nM - fm) < WGM ? (nM - fm) : WGM;
        u.pm = fm + ((wgid % nig) % gsz); u.pn = (wgid % nig) / gsz; return true;
    }
    __device__ __forceinline__ void a_ready(const Unit&) const {}
    __device__ __forceinline__ void done(const Unit&) const {}
};
__device__ __forceinline__ unsigned cvt_pk_bf16(float lo, float hi) { unsigned r; asm volatile("v_cvt_pk_bf16_f32 %0, %1, %2" : "=v"(r) : "v"(lo), "v"(hi)); return r; }
template <class Epi, class Sched, bool ALIGN_EPI = false, bool SP2 = false>
__device__ __forceinline__ void gemm_phase(PG8_LAS unsigned char* lds, const Gemm g, const Sched& S, const Epi& E) {
    int tid_ = threadIdx.x; asm volatile("" : "+v"(tid_));
    const int tid = tid_, wid = __builtin_amdgcn_readfirstlane(tid >> 6), lane = tid & 63, wr = wid >> 2, wc = wid & 3, fr = lane & 15, fq = lane >> 4;
    const int K = g.K, nt = K / BK;
    unsigned voffA, voffB;
    { int R, C; stage_rc(tid * 16, R, C); const int Rb = Epi::PERM ? ((R & ~31) + perm32(R & 31)) : R;
      voffA = (unsigned)(R * K + C) * 2u; voffB = (unsigned)(Rb * K + C) * 2u; }
    const size_t r64 = (size_t)64 * K * 2;
    const size_t kstep = (size_t)(BK * 2);
    const size_t hstep = (size_t)HALF * K * 2;
    const size_t tstep = 2 * hstep;
    const unsigned ldsw = (unsigned)wid * 1024u;
    const int aoff = lds_byte(wr * 64 + fr, fq * 8), boff = lds_byte(wc * 32 + fr, fq * 8);
#define PG8_SA(b, h) (((b) * 2 + (h)) * HTB)
#define PG8_SB(b, h) ((4 + (b) * 2 + (h)) * HTB)
#define PG8_STAGE(bufoff, gbase, voff) do { _Pragma("unroll") for (int _i = 0; _i < 2; ++_i) \
        __builtin_amdgcn_global_load_lds((const unsigned*)((const char*)(gbase) + (size_t)_i * r64 + (voff)), (PG8_LAS unsigned*)(lds + (bufoff) + ldsw + _i * 8192), 16, 0, 0); } while (0)
#define PG8_LDA(dst, b, h) do { _Pragma("unroll") for (int m = 0; m < 4; ++m) _Pragma("unroll") for (int k = 0; k < 2; ++k) dst[m][k] = *(const PG8_LAS bf16x8*)(lds + PG8_SA(b, h) + aoff + m * 2048 + k * 1024); } while (0)
#define PG8_LDB(dst, b, h) do { _Pragma("unroll") for (int n = 0; n < 2; ++n) _Pragma("unroll") for (int k = 0; k < 2; ++k) dst[n][k] = *(const PG8_LAS bf16x8*)(lds + PG8_SB(b, h) + boff + n * 2048 + k * 1024); } while (0)
#define PG8_MMA(ai, bj, At, Bt) do { __builtin_amdgcn_s_setprio(1); _Pragma("unroll") for (int m = 0; m < 4; ++m) _Pragma("unroll") for (int n = 0; n < 2; ++n) _Pragma("unroll") for (int k = 0; k < 2; ++k) \
        acc[ai][bj][m][n] = __builtin_amdgcn_mfma_f32_16x16x32_bf16(Bt[n][k], At[m][k], acc[ai][bj][m][n], 0, 0, 0); __builtin_amdgcn_s_setprio(0); } while (0)
#define PG8_WAIT_V(n) asm volatile("s_waitcnt vmcnt(" #n ")" ::: "memory")
#define PG8_WAIT_L(n) asm volatile("s_waitcnt lgkmcnt(" #n ")" ::: "memory")
#define PG8_BAR __builtin_amdgcn_s_barrier()
#define PG8_SCHED __builtin_amdgcn_sched_barrier(0)
    Unit cur, nxt; int ui = 0;
    if (!S.next(0, cur)) return;
    f32x4 acc[2][2][4][2];
#pragma unroll
    for (int a = 0; a < 2; ++a)
#pragma unroll
        for (int b = 0; b < 2; ++b)
#pragma unroll
            for (int m = 0; m < 4; ++m)
#pragma unroll
                for (int n = 0; n < 2; ++n) acc[a][b][m][n] = (f32x4){0.f, 0.f, 0.f, 0.f};
    bf16x8 At[4][2], B0[2][2], B1[2][2];
    const char* cA = (const char*)g.A + (size_t)cur.pm * tstep; const char* cB = (const char*)g.Bt + (size_t)cur.pn * tstep;
    S.a_ready(cur);
    if constexpr (SP2) {
        PG8_STAGE(PG8_SB(0, 0), cB, voffB); PG8_STAGE(PG8_SB(0, 1), cB + hstep, voffB); PG8_STAGE(PG8_SA(0, 0), cA, voffA); PG8_STAGE(PG8_SA(0, 1), cA + hstep, voffA);
        if (wr == 1) PG8_BAR;
        PG8_WAIT_V(2); PG8_BAR;
        PG8_STAGE(PG8_SB(1, 0), cB + kstep, voffB); PG8_STAGE(PG8_SA(1, 0), cA + kstep, voffA); PG8_STAGE(PG8_SB(1, 1), cB + hstep + kstep, voffB);
        PG8_WAIT_V(6); PG8_BAR;
    } else {
        PG8_STAGE(PG8_SB(0, 0), cB, voffB); PG8_STAGE(PG8_SA(0, 0), cA, voffA); PG8_STAGE(PG8_SB(0, 1), cB + hstep, voffB); PG8_STAGE(PG8_SA(0, 1), cA + hstep, voffA);
        if (wr == 1) PG8_BAR;
        PG8_WAIT_V(4); PG8_BAR;
        PG8_STAGE(PG8_SB(1, 0), cB + kstep, voffB); PG8_STAGE(PG8_SA(1, 0), cA + kstep, voffA); PG8_STAGE(PG8_SB(1, 1), cB + hstep + kstep, voffB);
        PG8_WAIT_V(6); PG8_BAR;
    }
    for (;;) {
        const bool has_next = S.next(ui + 1, nxt);
        const char* nA = has_next ? (const char*)g.A + (size_t)nxt.pm * tstep : cA; const char* nB = has_next ? (const char*)g.Bt + (size_t)nxt.pn * tstep : cB;
        for (int t = 0; t < nt; t += 2) {
            const bool last = (t == nt - 2);
            const char* a1 = cA + (size_t)(t + 1) * kstep;
            const char* a2 = last ? nA : cA + (size_t)(t + 2) * kstep; const char* b2 = last ? nB : cB + (size_t)(t + 2) * kstep;
            const char* a3 = a2 + kstep; const char* b3 = b2 + kstep;
            if (last && has_next) S.a_ready(nxt);
            if constexpr (SP2) {
            PG8_LDB(B0, 0, 0); PG8_LDB(B1, 0, 1); PG8_SCHED; PG8_LDA(At, 0, 0); PG8_STAGE(PG8_SA(1, 1), a1 + hstep, voffA);
            PG8_WAIT_V(8); PG8_WAIT_L(0); PG8_BAR; PG8_MMA(0, 0, At, B0); PG8_MMA(0, 1, At, B1); PG8_BAR; PG8_SCHED;
            PG8_LDA(At, 0, 1); PG8_STAGE(PG8_SB(0, 0), b2, voffB); PG8_STAGE(PG8_SB(0, 1), b2 + hstep, voffB); PG8_STAGE(PG8_SA(0, 0), a2, voffA);
            PG8_WAIT_V(8); PG8_WAIT_L(0); PG8_BAR; PG8_MMA(1, 0, At, B0); PG8_MMA(1, 1, At, B1); PG8_BAR; PG8_SCHED;
            PG8_LDB(B0, 1, 0); PG8_LDB(B1, 1, 1); PG8_SCHED; PG8_LDA(At, 1, 0); PG8_STAGE(PG8_SA(0, 1), a2 + hstep, voffA);
            PG8_WAIT_V(8); PG8_WAIT_L(0); PG8_BAR; PG8_MMA(0, 0, At, B0); PG8_MMA(0, 1, At, B1); PG8_BAR; PG8_SCHED;
            PG8_LDA(At, 1, 1); PG8_STAGE(PG8_SB(1, 0), b3, voffB); PG8_STAGE(PG8_SB(1, 1), b3 + hstep, voffB); PG8_STAGE(PG8_SA(1, 0), a3, voffA);
            PG8_WAIT_V(8); PG8_WAIT_L(0); PG8_BAR; PG8_MMA(1, 0, At, B0); PG8_MMA(1, 1, At, B1); PG8_BAR; PG8_SCHED;
            } else {
            PG8_LDB(B0, 0, 0); PG8_SCHED; PG8_LDA(At, 0, 0); PG8_STAGE(PG8_SA(1, 1), a1 + hstep, voffA);
            PG8_WAIT_L(8); PG8_BAR; PG8_WAIT_L(0); PG8_MMA(0, 0, At, B0); PG8_BAR; PG8_SCHED;
            PG8_LDB(B1, 0, 1); PG8_STAGE(PG8_SB(0, 0), b2, voffB);
            PG8_BAR; PG8_WAIT_L(0); PG8_MMA(0, 1, At, B1); PG8_BAR;
            PG8_LDA(At, 0, 1); PG8_STAGE(PG8_SA(0, 0), a2, voffA);
            PG8_BAR; PG8_WAIT_L(0); PG8_MMA(1, 0, At, B0); PG8_BAR; PG8_SCHED;
            PG8_STAGE(PG8_SB(0, 1), b2 + hstep, voffB);
            PG8_WAIT_V(6); PG8_BAR; PG8_MMA(1, 1, At, B1); PG8_BAR;
            PG8_LDB(B0, 1, 0); PG8_SCHED; PG8_LDA(At, 1, 0); PG8_STAGE(PG8_SA(0, 1), a2 + hstep, voffA);
            PG8_WAIT_L(8); PG8_BAR; PG8_WAIT_L(0); PG8_MMA(0, 0, At, B0); PG8_BAR; PG8_SCHED;
            PG8_LDB(B1, 1, 1); PG8_STAGE(PG8_SB(1, 0), b3, voffB);
            PG8_BAR; PG8_WAIT_L(0); PG8_MMA(0, 1, At, B1); PG8_BAR;
            PG8_LDA(At, 1, 1); PG8_STAGE(PG8_SA(1, 0), a3, voffA);
            PG8_BAR; PG8_WAIT_L(0); PG8_MMA(1, 0, At, B0); PG8_BAR; PG8_SCHED;
            PG8_STAGE(PG8_SB(1, 1), b3 + hstep, voffB);
            PG8_WAIT_V(6); PG8_BAR; PG8_MMA(1, 1, At, B1); PG8_BAR;
            }
        }
        if constexpr (ALIGN_EPI) { if (wr == 0) PG8_BAR; }
        if constexpr (!Epi::AFTER_DRAIN) { E(acc, cur, wr, wc, fr, fq); S.done(cur); }
        if (!has_next) break;
#pragma unroll
        for (int a = 0; a < 2; ++a)
#pragma unroll
            for (int b = 0; b < 2; ++b)
#pragma unroll
                for (int m = 0; m < 4; ++m)
#pragma unroll
                    for (int n = 0; n < 2; ++n) acc[a][b][m][n] = (f32x4){0.f, 0.f, 0.f, 0.f};
        cur = nxt; cA = nA; cB = nB; ++ui;
        if constexpr (ALIGN_EPI) { if (wr == 1) PG8_BAR; }
    }
    PG8_WAIT_V(0);
    if constexpr (!ALIGN_EPI) { if (wr == 0) PG8_BAR; }
    PG8_BAR;
    if constexpr (Epi::AFTER_DRAIN) { E.fused(acc, cur, wr, wc, fr, fq, lds, wid, lane); S.done(cur); }
#undef PG8_SA
#undef PG8_SB
#undef PG8_STAGE
#undef PG8_LDA
#undef PG8_LDB
#undef PG8_MMA
#undef PG8_WAIT_V
#undef PG8_WAIT_L
#undef PG8_BAR
#undef PG8_SCHED
}
}

#define GAS __attribute__((address_space(1)))
#define LAS __attribute__((address_space(3)))
typedef unsigned short bf16;
typedef unsigned v4u __attribute__((ext_vector_type(4)));
typedef unsigned v2u __attribute__((ext_vector_type(2)));
typedef float f32x4 __attribute__((ext_vector_type(4)));
typedef float f32x16 __attribute__((ext_vector_type(16)));
typedef short bf16x8 __attribute__((ext_vector_type(8)));
typedef __bf16 bf16x2_t __attribute__((ext_vector_type(2)));
typedef float f32x2_t __attribute__((ext_vector_type(2)));
#define LDS_WAIT() asm volatile("s_waitcnt lgkmcnt(0)" ::: "memory")
#define MFMA32(a, b, c) __builtin_amdgcn_mfma_f32_32x32x16_bf16((a), (b), (c), 0, 0, 0)

constexpr int M = 32768, D = 1024, S = 2048, NBATCH = 16, FF = 2816, DIN = 9094, NQKV = 5120;
constexpr float LOG2E = 1.4426950408889634f, LN2 = 0.6931471805599453f;
constexpr float QSCALE = 0.125f * LOG2E;
constexpr float RMS_EPS = 1e-6f;
constexpr size_t MiB = 1u << 20;
constexpr size_t WS_CTL = 0, WS_LOGF = 1 * MiB, WS_W = 2 * MiB, W_LAYER = 56 * MiB, WS_HN = 114 * MiB, WS_BIG = 178 * MiB, WS_RSP = 507 * MiB, WS_END = 509 * MiB;
constexpr size_t W_1T = 0, W_2T = 11 * MiB, W_INT = 16 * MiB + MiB / 2, W_GT = 26 * MiB + MiB / 2, W_BRT = 34 * MiB + MiB / 2, W_OT = 37 * MiB + MiB / 2,
                 W_3T = 39 * MiB + MiB / 2, W_4T = 50 * MiB + MiB / 2;
constexpr size_t WB_A = 0, WB_B = 1 * MiB, WB_C = 1 * MiB + 3 * MiB / 4, WB_D = 2 * MiB + MiB / 2;
constexpr size_t B_QA = 0, B_QB = 32 * MiB, B_QC = 56 * MiB, B_OD = 80 * MiB, B_KA = 96 * MiB, B_VA = 128 * MiB, B_KB = 160 * MiB, B_VB = 184 * MiB,
                 B_KC = 208 * MiB, B_VC = 232 * MiB, B_QD = 256 * MiB, B_KD = 280 * MiB, B_VD = 304 * MiB;
constexpr size_t B_P = 96 * MiB, B_TMP = 160 * MiB, B_MRG = 224 * MiB;
constexpr int LDS_BYTES = 156672, LDS_BST = 155648 + 64;
constexpr int NTHREADS = 512;

struct Params;
typedef const __attribute__((address_space(4))) Params* PPtr;
struct Params {
    const float* in[22];
    float* out;
    unsigned char* ws;
    float lam_init[2];
    float one_minus_lam_init[2];
};

__device__ __forceinline__ int opaque_tid() { int t = threadIdx.x; asm volatile("" : "+v"(t)); return t; }
__device__ __forceinline__ unsigned f2bf(float f) { unsigned u = __builtin_bit_cast(unsigned, f); return (u + 0x7fffu + ((u >> 16) & 1u)) >> 16; }
__device__ __forceinline__ unsigned pk2(float lo, float hi) { f32x2_t v = {lo, hi}; bf16x2_t b = __builtin_convertvector(v, bf16x2_t); return __builtin_bit_cast(unsigned, b); }
__device__ __forceinline__ float bflo(unsigned w) { return __builtin_bit_cast(float, w << 16); }
__device__ __forceinline__ float bfhi(unsigned w) { return __builtin_bit_cast(float, w & 0xffff0000u); }
__device__ __forceinline__ float fexp2(float x) { return __builtin_amdgcn_exp2f(x); }
__device__ __forceinline__ float flog2(float x) { return __builtin_amdgcn_logf(x); }
__device__ __forceinline__ float sigmoidf_(float x) { return __builtin_amdgcn_rcpf(1.0f + fexp2(-x * LOG2E)); }
__device__ __forceinline__ float row_rs(const float* rsp, int row) {
    const f32x4* q = (const f32x4*)(rsp + (size_t)row * 16);
    const f32x4 a = q[0], b = q[1], c = q[2], d = q[3];
    const float s = ((a[0] + a[1]) + (a[2] + a[3])) + ((b[0] + b[1]) + (b[2] + b[3])) + ((c[0] + c[1]) + (c[2] + c[3])) + ((d[0] + d[1]) + (d[2] + d[3]));
    return rsqrtf(s * (1.0f / 1024.0f) + 1e-6f);
}
__device__ __forceinline__ float wave_sum(float v) {
#pragma unroll
    for (int o = 1; o < 64; o <<= 1) v += __shfl_xor(v, o);
    return v;
}

typedef const pg8::f32x4 (&AccRef)[2][2][4][2];

struct EpiSwiglu {
    static constexpr bool PERM = true, AFTER_DRAIN = false;
    bf16* U; const LAS float* rst;
    __device__ __forceinline__ void operator()(AccRef acc, const pg8::Unit& u, int wr, int wc, int fr, int fq) const {
        const int row0 = u.pm * 256 + wr * 64 + fr, col0 = u.pn * 128 + wc * 32 + 8 * fq;
#pragma unroll
        for (int ai = 0; ai < 2; ++ai)
#pragma unroll
            for (int m = 0; m < 4; ++m) {
                const int row = row0 + ai * 128 + m * 16;
                const float rs = rst[row & 255];
                float v[8];
#pragma unroll
                for (int n = 0; n < 2; ++n)
#pragma unroll
                    for (int j = 0; j < 4; ++j) { const float g = acc[ai][0][m][n][j] * rs, up = acc[ai][1][m][n][j] * rs; v[4 * n + j] = g * sigmoidf_(g) * up; }
                v4u w; w.x = pk2(v[0], v[1]); w.y = pk2(v[2], v[3]); w.z = pk2(v[4], v[5]); w.w = pk2(v[6], v[7]);
                *(v4u*)(U + (size_t)row * FF + col0) = w;
            }
    }
};

struct EpiResid {
    static constexpr bool PERM = true, AFTER_DRAIN = false;
    bf16* xb; float* outf; float scale; float* rss;
    __device__ __forceinline__ void operator()(AccRef acc, const pg8::Unit& u, int wr, int wc, int fr, int fq) const {
        const int row0 = u.pm * 256 + wr * 64 + fr, col0 = u.pn * 256 + wc * 32 + 8 * fq;
#pragma unroll
        for (int ai = 0; ai < 2; ++ai) {
            v4u xw[4][2];
#pragma unroll
            for (int m = 0; m < 4; ++m)
#pragma unroll
                for (int bj = 0; bj < 2; ++bj) xw[m][bj] = *(const v4u*)(xb + (size_t)(row0 + ai * 128 + m * 16) * D + col0 + bj * 128);
#pragma unroll
            for (int m = 0; m < 4; ++m) {
                const int row = row0 + ai * 128 + m * 16;
                float ss = 0.f;
#pragma unroll
                for (int bj = 0; bj < 2; ++bj) {
                    const size_t p = (size_t)row * D + col0 + bj * 128;
                    const v4u w0 = xw[m][bj];
                    f32x4 a = {bflo(w0.x), bfhi(w0.x), bflo(w0.y), bfhi(w0.y)}, b = {bflo(w0.z), bfhi(w0.z), bflo(w0.w), bfhi(w0.w)};
                    a = a + acc[ai][bj][m][0] * scale; b = b + acc[ai][bj][m][1] * scale;
                    if (outf) { *(f32x4*)(outf + p) = a; *(f32x4*)(outf + p + 4) = b; }
                    else {
                        ss += (a[0] * a[0] + a[1] * a[1]) + (a[2] * a[2] + a[3] * a[3]) + (b[0] * b[0] + b[1] * b[1]) + (b[2] * b[2] + b[3] * b[3]);
                        v4u w; w.x = pk2(a[0], a[1]); w.y = pk2(a[2], a[3]); w.z = pk2(b[0], b[1]); w.w = pk2(b[2], b[3]);
                        *(v4u*)(xb + p) = w;
                    }
                }
                if (!outf) {
                    ss += __shfl_xor(ss, 16); ss += __shfl_xor(ss, 32);
                    if (fq == 0) rss[(size_t)row * 16 + u.pn * 4 + wc] = ss;
                }
            }
        }
    }
};

struct EpiQKV {
    static constexpr bool PERM = true, AFTER_DRAIN = false;
    unsigned char* big; const float *aq, *ak, *cq, *ck, *dq, *dk, *fb; float* logf; const LAS float* rst;
    __device__ __forceinline__ void operator()(AccRef acc, const pg8::Unit& u, int wr, int wc, int fr, int fq) const {
        const int G = u.pn * 4 + wc;
        if (G >= 79) return;
        const int row0 = u.pm * 256 + wr * 64 + fr;
        if (G == 78) {
            if (fq == 0) {
#pragma unroll
                for (int ai = 0; ai < 2; ++ai)
#pragma unroll
                    for (int m = 0; m < 4; ++m) {
                        const int row = row0 + ai * 128 + m * 16;
                        const float rsr = rst[row & 255];
#pragma unroll
                        for (int e = 0; e < 6; ++e) {
                            const float x = acc[ai][0][m][e >> 2][e & 3] * rsr + fb[e];
                            const float ls = fminf(x, 0.f) - LN2 * flog2(1.0f + fexp2(-fabsf(x) * LOG2E));
                            logf[(size_t)row * 8 + e] = ls;
                        }
                    }
            }
            return;
        }
        size_t off; int pitch, lg; const float* gain = nullptr; float sc = 1.f;
        if (G < 8)       { off = B_QA; pitch = 512; lg = G;      gain = aq; sc = QSCALE; }
        else if (G < 16) { off = B_KA; pitch = 512; lg = G - 8;  gain = ak; }
        else if (G < 24) { off = B_VA; pitch = 512; lg = G - 16; }
        else if (G < 30) { off = B_QB; pitch = 384; lg = G - 24; sc = QSCALE; }
        else if (G < 36) { off = B_KB; pitch = 384; lg = G - 30; }
        else if (G < 42) { off = B_VB; pitch = 384; lg = G - 36; }
        else if (G < 48) { off = B_QC; pitch = 384; lg = G - 42; gain = cq; sc = QSCALE; }
        else if (G < 54) { off = B_KC; pitch = 384; lg = G - 48; gain = ck; }
        else if (G < 60) { off = B_VC; pitch = 384; lg = G - 54; }
        else if (G < 66) { off = B_QD; pitch = 384; lg = G - 60; gain = dq; sc = QSCALE; }
        else if (G < 72) { off = B_KD; pitch = 384; lg = G - 66; gain = dk; }
        else             { off = B_VD; pitch = 384; lg = G - 72; }
        bf16* dst = (bf16*)(big + off) + lg * 64 + 8 * fq;
        f32x4 gv[2][2];
#pragma unroll
        for (int bj = 0; bj < 2; ++bj)
#pragma unroll
            for (int n = 0; n < 2; ++n) {
                f32x4 g4 = {1.f, 1.f, 1.f, 1.f};
                if (gain) g4 = *(const f32x4*)(gain + 32 * bj + 8 * fq + 4 * n);
                gv[bj][n] = g4 * sc;
            }
#pragma unroll
        for (int ai = 0; ai < 2; ++ai)
#pragma unroll
            for (int m = 0; m < 4; ++m) {
                const int row = row0 + ai * 128 + m * 16;
                const float rsr = rst[row & 255];
                f32x4 xv[2][2];
#pragma unroll
                for (int bj = 0; bj < 2; ++bj)
#pragma unroll
                    for (int n = 0; n < 2; ++n) xv[bj][n] = acc[ai][bj][m][n] * rsr;
                float rs = 1.f;
                if (gain) {
                    float ss = 0.f;
#pragma unroll
                    for (int bj = 0; bj < 2; ++bj)
#pragma unroll
                        for (int n = 0; n < 2; ++n) { const f32x4 x = xv[bj][n]; ss += (x[0] * x[0] + x[1] * x[1]) + (x[2] * x[2] + x[3] * x[3]); }
                    ss += __shfl_xor(ss, 16); ss += __shfl_xor(ss, 32);
                    rs = rsqrtf(ss * (1.0f / 64.0f) + RMS_EPS);
                }
#pragma unroll
                for (int bj = 0; bj < 2; ++bj) {
                    const f32x4 v0 = xv[bj][0] * rs * gv[bj][0], v1 = xv[bj][1] * rs * gv[bj][1];
                    v4u w; w.x = pk2(v0[0], v0[1]); w.y = pk2(v0[2], v0[3]); w.z = pk2(v1[0], v1[1]); w.w = pk2(v1[2], v1[3]);
                    *(v4u*)(dst + (size_t)row * pitch + 32 * bj) = w;
                }
            }
    }
};

struct EpiPStore {
    static constexpr bool PERM = true, AFTER_DRAIN = false;
    v4u* P;
    __device__ __forceinline__ void operator()(AccRef acc, const pg8::Unit& u, int wr, int wc, int fr, int fq) const {
        v4u* base = P + (size_t)(u.pm * 4 + u.pn) * 16 * NTHREADS + opaque_tid();
#pragma unroll
        for (int ai = 0; ai < 2; ++ai)
#pragma unroll
            for (int bj = 0; bj < 2; ++bj)
#pragma unroll
                for (int m = 0; m < 4; ++m) {
                    const f32x4 v0 = acc[ai][bj][m][0], v1 = acc[ai][bj][m][1];
                    v4u w; w.x = pk2(v0[0], v0[1]); w.y = pk2(v0[2], v0[3]); w.z = pk2(v1[0], v1[1]); w.w = pk2(v1[2], v1[3]);
                    base[(size_t)((ai * 2 + bj) * 4 + m) * NTHREADS] = w;
                    }
    }
};

struct EpiGate {
    static constexpr bool PERM = true, AFTER_DRAIN = false;
    const float* gb; const v4u* P; v4u* TMP; bf16* MRG; int first, last; const LAS float* rst;
    __device__ __forceinline__ void operator()(AccRef acc, const pg8::Unit& u, int wr, int wc, int fr, int fq) const {
        const size_t ub = (size_t)(u.pm * 4 + u.pn) * 16 * NTHREADS + opaque_tid();
        const int row0 = u.pm * 256 + wr * 64 + fr, col0 = u.pn * 256 + wc * 32 + 8 * fq;
#pragma unroll
        for (int bj = 0; bj < 2; ++bj) {
            const f32x4 bv0 = *(const f32x4*)(gb + col0 + bj * 128), bv1 = *(const f32x4*)(gb + col0 + bj * 128 + 4);
#pragma unroll
            for (int ai = 0; ai < 2; ++ai) {
                v4u pw4[4], tw4[4];
#pragma unroll
                for (int m = 0; m < 4; ++m) {
                    const size_t ci = ub + (size_t)((ai * 2 + bj) * 4 + m) * NTHREADS;
                    pw4[m] = P[ci];
                    if (!first) tw4[m] = TMP[ci]; else tw4[m] = (v4u){0u, 0u, 0u, 0u};
                }
#pragma unroll
                for (int m = 0; m < 4; ++m) {
                    const size_t ci = ub + (size_t)((ai * 2 + bj) * 4 + m) * NTHREADS;
                    const v4u pw = pw4[m], tw = tw4[m];
                    const float rs = rst[(row0 + ai * 128 + m * 16) & 255];
                    float v[8];
                    v[0] = sigmoidf_(acc[ai][bj][m][0][0] * rs + bv0[0]) * bflo(pw.x); v[1] = sigmoidf_(acc[ai][bj][m][0][1] * rs + bv0[1]) * bfhi(pw.x);
                    v[2] = sigmoidf_(acc[ai][bj][m][0][2] * rs + bv0[2]) * bflo(pw.y); v[3] = sigmoidf_(acc[ai][bj][m][0][3] * rs + bv0[3]) * bfhi(pw.y);
                    v[4] = sigmoidf_(acc[ai][bj][m][1][0] * rs + bv1[0]) * bflo(pw.z); v[5] = sigmoidf_(acc[ai][bj][m][1][1] * rs + bv1[1]) * bfhi(pw.z);
                    v[6] = sigmoidf_(acc[ai][bj][m][1][2] * rs + bv1[2]) * bflo(pw.w); v[7] = sigmoidf_(acc[ai][bj][m][1][3] * rs + bv1[3]) * bfhi(pw.w);
                    v[0] += bflo(tw.x); v[1] += bfhi(tw.x); v[2] += bflo(tw.y); v[3] += bfhi(tw.y);
                    v[4] += bflo(tw.z); v[5] += bfhi(tw.z); v[6] += bflo(tw.w); v[7] += bfhi(tw.w);
                    v4u w; w.x = pk2(v[0], v[1]); w.y = pk2(v[2], v[3]); w.z = pk2(v[4], v[5]); w.w = pk2(v[6], v[7]);
                    if (!last) TMP[ci] = w;
                    else *(v4u*)(MRG + (size_t)(row0 + ai * 128 + m * 16) * D + col0 + bj * 128) = w;
                }
            }
        }
    }
};

__device__ __forceinline__ void tr_item(const float* src, int ldw, int k0, int n0, bf16* dst, int ldt, int drow0, int dk0, LAS float* scr, int lane, const float* gk = nullptr) {
#pragma unroll 8
    for (int i = 0; i < 32; ++i) { const int kk = 2 * i + (lane >> 5); scr[kk * 33 + (lane & 31)] = src[(size_t)(k0 + kk) * ldw + n0 + (lane & 31)]; }
    LDS_WAIT(); asm volatile("" ::: "memory");
    const int c = lane & 7;
    f32x4 g0 = {1.f, 1.f, 1.f, 1.f}, g1 = g0;
    if (gk) { g0 = *(const f32x4*)(gk + k0 + 8 * c); g1 = *(const f32x4*)(gk + k0 + 8 * c + 4); }
#pragma unroll
    for (int j = 0; j < 4; ++j) {
        const int n = (lane >> 3) + 8 * j; const LAS float* sp = scr + (8 * c) * 33 + n;
        v4u o; o.x = pk2(sp[0 * 33] * g0[0], sp[1 * 33] * g0[1]); o.y = pk2(sp[2 * 33] * g0[2], sp[3 * 33] * g0[3]);
        o.z = pk2(sp[4 * 33] * g1[0], sp[5 * 33] * g1[1]); o.w = pk2(sp[6 * 33] * g1[2], sp[7 * 33] * g1[3]);
        *(v4u*)(dst + (size_t)(drow0 + n) * ldt + dk0 + 8 * c) = o;
    }
    LDS_WAIT(); asm volatile("" ::: "memory");
}

constexpr int NJ1 = 2816, NJ2 = 1408, NJ3 = 2496, NJ4 = 2048, NJ5A = 256, NJ5B = 192, NJ5C = 192, NJ5D = 64, NJ6 = 512;
constexpr int NPL = NJ1 + NJ2 + NJ3 + NJ4 + NJ5A + NJ5B + NJ5C + NJ5D + NJ6 + NJ1 + NJ2;

__device__ __forceinline__ void ffn_in_item(const float* w, bf16* dst, int r, LAS float* scr, int lane, const float* gk) {
    const int kb = r / 176, nb = r % 176, c0 = 32 * nb;
    const int drow = (c0 < FF) ? 256 * (c0 / 128) + (c0 % 128) : 256 * ((c0 - FF) / 128) + 128 + ((c0 - FF) % 128);
    tr_item(w, 2 * FF, 64 * kb, c0, dst, D, drow, 64 * kb, scr, lane, gk);
}
__device__ __forceinline__ void plain_item(const float* w, int ldw, int krow0, bf16* dst, int ldt, int r, LAS float* scr, int lane) {
    const int kb = r >> 5, nb = r & 31;
    tr_item(w, ldw, krow0 + 64 * kb, 32 * nb, dst, ldt, 32 * nb, 64 * kb, scr, lane);
}

__device__ __forceinline__ void prologue_weights(const Params& p, LAS unsigned char* lds) {
    const int tid = threadIdx.x, lane = tid & 63, wave = tid >> 6;
    LAS float* scr = (LAS float*)(lds + wave * 16384);
    const int gw = blockIdx.x * 8 + wave, NGW = gridDim.x * 8;
    for (int it = gw; it < 2 * NPL; it += NGW) {
        const int l = it / NPL; int r = it % NPL;
        unsigned char* wb = p.ws + WS_W + (size_t)l * W_LAYER;
        if (r < NJ1) { ffn_in_item(p.in[3] + (size_t)l * D * 2 * FF, (bf16*)(wb + W_1T), r, scr, lane, p.in[2] + (size_t)l * D); continue; } r -= NJ1;
        if (r < NJ2) { plain_item(p.in[4] + (size_t)l * FF * D, D, 0, (bf16*)(wb + W_2T), FF, r, scr, lane); continue; } r -= NJ2;
        if (r < NJ3) {
            const int kb = r / 156, nb = r % 156, L0 = 32 * nb, n0 = (L0 < 3840) ? L0 : L0 + 6;
            const int drow = 256 * (L0 >> 8) + 128 * ((L0 & 63) >> 5) + 32 * ((L0 >> 6) & 3);
            tr_item(p.in[6] + (size_t)l * D * DIN, DIN, 64 * kb, n0, (bf16*)(wb + W_INT), D, drow, 64 * kb, scr, lane, p.in[5] + (size_t)l * D); continue; } r -= NJ3;
        if (r < NJ4) {
            const int kb = r >> 7, nb = r & 127;
            tr_item(p.in[6] + (size_t)l * D * DIN, DIN, 64 * kb, 4998 + 32 * nb, (bf16*)(wb + W_GT), D, 32 * nb, 64 * kb, scr, lane, p.in[5] + (size_t)l * D); continue; } r -= NJ4;
        const float* wbr = p.in[17] + (size_t)l * 1408 * D;
        if (r < NJ5A) { plain_item(wbr, D, 0, (bf16*)(wb + W_BRT + WB_A), 512, r, scr, lane); continue; } r -= NJ5A;
        if (r < NJ5B) { plain_item(wbr, D, 512, (bf16*)(wb + W_BRT + WB_B), 384, r, scr, lane); continue; } r -= NJ5B;
        if (r < NJ5C) { plain_item(wbr, D, 896, (bf16*)(wb + W_BRT + WB_C), 384, r, scr, lane); continue; } r -= NJ5C;
        if (r < NJ5D) { plain_item(wbr, D, 1280, (bf16*)(wb + W_BRT + WB_D), 256, r, scr, lane); continue; } r -= NJ5D;
        if (r < NJ6) { plain_item(p.in[18] + (size_t)l * D * D, D, 0, (bf16*)(wb + W_OT), D, r, scr, lane); continue; } r -= NJ6;
        if (r < NJ1) { ffn_in_item(p.in[20] + (size_t)l * D * 2 * FF, (bf16*)(wb + W_3T), r, scr, lane, p.in[19] + (size_t)l * D); continue; } r -= NJ1;
        plain_item(p.in[21] + (size_t)l * FF * D, D, 0, (bf16*)(wb + W_4T), FF, r, scr, lane);
    }
    const int gt = blockIdx.x * NTHREADS + tid, NGT = gridDim.x * NTHREADS;
    for (int i = gt; i < 2 * 131072; i += NGT) {
        const int l = i >> 17, q = i & 131071;
        unsigned char* wb = p.ws + WS_W + (size_t)l * W_LAYER;
        { const int idx = q >> 10, k = q & 1023, R = 4864 + (idx >> 6) * 128 + 64 + (idx & 63), e = R - 4928;
          float v = 0.f; if (e >= 0 && e < 6) v = p.in[6][(size_t)l * D * DIN + (size_t)k * DIN + 3840 + e] * p.in[5][(size_t)l * D + k];
          ((bf16*)(wb + W_INT))[(size_t)R * D + k] = (bf16)f2bf(v); }
        { const int row = q >> 7, col = 128 + (q & 127); ((bf16*)(wb + W_BRT + WB_D))[(size_t)row * 256 + col] = 0; }
    }
}

__device__ __forceinline__ void norm_phase(const float* x, bf16* hn, float* rss) {
    const int tid = opaque_tid(), lane = tid & 63, wave = tid >> 6;
    const int gw = blockIdx.x * 8 + wave, NGW = gridDim.x * 8;
    for (int row = gw; row < M; row += NGW) {
        const f32x4* xr = (const f32x4*)(x + (size_t)row * D) + lane;
        f32x4 v[4]; float sq = 0.f;
#pragma unroll
        for (int j = 0; j < 4; ++j) { v[j] = xr[64 * j]; sq += (v[j][0] * v[j][0] + v[j][1] * v[j][1]) + (v[j][2] * v[j][2] + v[j][3] * v[j][3]); }
        sq = wave_sum(sq);
        if (lane < 16) rss[(size_t)row * 16 + lane] = (lane == 0) ? sq : 0.f;
        v2u* o8 = (v2u*)(hn + (size_t)row * D) + lane;
#pragma unroll
        for (int j = 0; j < 4; ++j) { v2u w; w.x = pk2(v[j][0], v[j][1]); w.y = pk2(v[j][2], v[j][3]); o8[64 * j] = w; }
    }
}

constexpr int KPITCH = 72;
constexpr int AL_KS0 = 0, AL_KS1 = 9216, AL_VT0 = 36864, AL_VT1 = 54272, AL_LUT = 73728, AL_CB = 75776, AL_SCAN = 83968, AL_ITEM = 84032, AL_O0 = 86016;
constexpr float NEG_BIG = -1.0e4f;

template <int DV> struct TileRegs { v4u k; v4u v[DV / 64]; };

template <int DV> __device__ __forceinline__ void tile_load(TileRegs<DV>& R, const bf16* Kp, int kpitch, const bf16* Vp, int vpitch, int k0, int tid) {
    const int key = tid >> 3, c = tid & 7;
    R.k = *(const v4u*)(Kp + (unsigned)((k0 + key) * kpitch + 8 * c));
#pragma unroll
    for (int i = 0; i < DV / 64; ++i) R.v[i] = *(const v4u*)(Vp + (unsigned)((k0 + key) * vpitch + 64 * i + 8 * c));
}
template <int DV> __device__ __forceinline__ void tile_store(const TileRegs<DV>& R, LAS unsigned char* ks, LAS unsigned char* vt, int tid) {
    const int key = tid >> 3, c = tid & 7;
    *(LAS v4u*)(ks + (key * KPITCH + 8 * c) * 2) = R.k;
#pragma unroll
    for (int i = 0; i < DV / 64; ++i) *(LAS v4u*)(vt + (key * (DV + 8) + 64 * i + 8 * c) * 2) = R.v[i];
}
__device__ __forceinline__ bf16x8 pack8(const f32x16& s, int st) {
    v4u w;
    if (st == 0) { w.x = pk2(s[0], s[1]); w.y = pk2(s[2], s[3]); w.z = pk2(s[4], s[5]); w.w = pk2(s[6], s[7]); }
    else         { w.x = pk2(s[8], s[9]); w.y = pk2(s[10], s[11]); w.z = pk2(s[12], s[13]); w.w = pk2(s[14], s[15]); }
    return __builtin_bit_cast(bf16x8, w);
}
typedef short v4i16_t __attribute__((ext_vector_type(4)));
template <int DV> __device__ __forceinline__ bf16x8 vfrag(LAS unsigned char* vt, int dv0, int kbase, int lane) {
    const int i16 = lane & 15, q = i16 >> 2, pp_ = i16 & 3, blk = (lane >> 4) & 1;
    LAS unsigned char* p0 = vt + ((kbase + q) * (DV + 8) + dv0 + 16 * blk + 4 * pp_) * 2;
    const v4i16_t lo = __builtin_amdgcn_ds_read_tr16_b64_v4i16((LAS v4i16_t*)p0);
    const v4i16_t hi = __builtin_amdgcn_ds_read_tr16_b64_v4i16((LAS v4i16_t*)(p0 + 8 * (DV + 8) * 2));
    return __builtin_shufflevector(lo, hi, 0, 1, 2, 3, 4, 5, 6, 7);
}
__device__ __forceinline__ int rel_bucket(int n) {
    if (n < 16) return n;
    return 16 + (n >= 19) + (n >= 21) + (n >= 24) + (n >= 27) + (n >= 31) + (n >= 35) + (n >= 40) + (n >= 46) + (n >= 52) + (n >= 59) + (n >= 67) + (n >= 77) + (n >= 87) + (n >= 99) + (n >= 113);
}

template <int KIND>
__device__ __forceinline__ void softmax_tile(f32x16& s0, f32x16& s1, float& l, int t, int k0, int h, int qlo, const LAS float* lut, const LAS float* cb, int W, int dmask, float rowshift) {
    const float NINF = -__builtin_inff();
    if (KIND == 0) {
        if (k0 + 63 + 128 <= qlo) {
            const float c = lut[128];
#pragma unroll
            for (int i = 0; i < 16; ++i) { s0[i] += c; s1[i] += c; }
        } else {
#pragma unroll
            for (int i = 0; i < 16; ++i) {
                const int j0 = k0 + (i & 3) + 8 * (i >> 2) + 4 * h, n0 = t - j0, n1 = n0 - 32;
                const float b0 = lut[min(max(n0, 0), 128)], b1 = lut[min(max(n1, 0), 128)];
                s0[i] = (n0 >= 0) ? s0[i] + b0 : NINF; s1[i] = (n1 >= 0) ? s1[i] + b1 : NINF;
            }
        }
    } else if (KIND == 1) {
        const bool diag = (k0 + 63 > qlo);
#pragma unroll
        for (int c = 0; c < 4; ++c) {
            const f32x4 b0 = *(const LAS f32x4*)(cb + k0 + 8 * c + 4 * h), b1 = *(const LAS f32x4*)(cb + k0 + 32 + 8 * c + 4 * h);
#pragma unroll
            for (int jj = 0; jj < 4; ++jj) {
                const int i = 4 * c + jj; const int n0 = t - (k0 + 8 * c + 4 * h + jj), n1 = n0 - 32;
                float x0 = s0[i] + (b0[jj] + rowshift), x1 = s1[i] + (b1[jj] + rowshift);
                if (diag) { x0 = (n0 >= 0) ? x0 : NINF; x1 = (n1 >= 0) ? x1 : NINF; }
                s0[i] = x0; s1[i] = x1;
            }
        }
    } else {
#pragma unroll
        for (int i = 0; i < 16; ++i) {
            const int j0 = k0 + (i & 3) + 8 * (i >> 2) + 4 * h, n0 = t - j0, n1 = n0 - 32;
            const float b0 = lut[min(max(n0, 0), 128)], b1 = lut[min(max(n1, 0), 128)];
            const bool v0 = (n0 >= 0) && (n0 <= W) && ((n0 & dmask) == 0), v1 = (n1 >= 0) && (n1 <= W) && ((n1 & dmask) == 0);
            s0[i] = v0 ? s0[i] + b0 : NINF; s1[i] = v1 ? s1[i] + b1 : NINF;
        }
    }
    float ps = 0.f;
#pragma unroll
    for (int i = 0; i < 16; ++i) { s0[i] = fexp2(s0[i]); s1[i] = fexp2(s1[i]); ps += s0[i] + s1[i]; }
    l += ps;
}

__device__ __forceinline__ void stick_block(f32x16& s, float& Rr, int t, int kbase, int h, bool diag) {
    float u[16], gs[4], pg[4];
#pragma unroll
    for (int i = 0; i < 16; ++i) {
        const float z = s[i];
        const float sp = fmaxf(z, 0.f) + flog2(1.0f + fexp2(-fabsf(z)));
        const int j = kbase + (i & 3) + 8 * (i >> 2) + 4 * h;
        const bool valid = !diag || (j < t);
        u[i] = valid ? -sp : 0.f;
        s[i] = valid ? (z - sp) : -__builtin_inff();
    }
#pragma unroll
    for (int c = 0; c < 4; ++c) { gs[c] = (u[4 * c] + u[4 * c + 1]) + (u[4 * c + 2] + u[4 * c + 3]); pg[c] = __shfl_xor(gs[c], 32); }
    float run = Rr;
#pragma unroll
    for (int c = 3; c >= 0; --c) {
        float tl = run + ((h == 0) ? pg[c] : 0.f);
#pragma unroll
        for (int jj = 3; jj >= 0; --jj) { const int i = 4 * c + jj; const float a = fexp2(s[i] + tl); tl += u[i]; s[i] = a; }
        run += gs[c] + pg[c];
    }
    Rr = run;
}

template <int KIND  , int DV>
__device__ __forceinline__ void attn_pass(LAS unsigned char* L, const bf16* Qp, int qpitch, const bf16* Kp, int kpitch, const bf16* Vp, int vpitch,
                                          int q0w, int t_lo, int t_hi, f32x16 (&o)[DV / 32], const float bnd, float& l, float& Rr,
                                          const LAS float* lut, const LAS float* cb, int W, int dmask, const int tid, const bool wave_on = true) {
    const int lane = tid & 63, r = lane & 31, h = lane >> 5;
    const int t = q0w + r, qlo = q0w, qhi = wave_on ? q0w + 31 : -1;
    bf16x8 qf[4];
#pragma unroll
    for (int ks = 0; ks < 4; ++ks) qf[ks] = *(const bf16x8*)(Qp + (unsigned)((wave_on ? t : 0) * qpitch + 16 * ks + 8 * h));
    TileRegs<DV> TA, TB;
    __syncthreads();
    tile_load<DV>(TA, Kp, kpitch, Vp, vpitch, t_hi * 64, tid);
    tile_store<DV>(TA, L + AL_KS0, L + AL_VT0, tid);
    if (t_hi - 1 >= t_lo) tile_load<DV>(TA, Kp, kpitch, Vp, vpitch, (t_hi - 1) * 64, tid);
    float rowshift = 0.f;
    if (KIND == 1) rowshift = -cb[t] - bnd;
    int buf = 0;
#define ATTN_STEP(TCUR, TNXT)                                                                                                          \
    {                                                                                                                                   \
        __syncthreads();                                                                                                                \
        if (tt - 2 >= t_lo) tile_load<DV>(TNXT, Kp, kpitch, Vp, vpitch, (tt - 2) * 64, tid);                                            \
        const int k0 = tt * 64;                                                                                                         \
        bool active = (k0 <= qhi);                                                                                                      \
        if (KIND == 2) active = active && (k0 + 63 >= qlo - W);                                                                         \
        if (active) {                                                                                                                   \
            LAS unsigned char* ks = L + (buf ? AL_KS1 : AL_KS0);                                                                        \
            LAS unsigned char* vt = L + (buf ? AL_VT1 : AL_VT0);                                                                        \
            f32x16 s0, s1;                                                                                                              \
            _Pragma("unroll") for (int i = 0; i < 16; ++i) { s0[i] = 0.f; s1[i] = 0.f; }                                                \
            _Pragma("unroll") for (int kk = 0; kk < 4; ++kk) {                                                                          \
                const bf16x8 a0 = *(const LAS bf16x8*)(ks + (r * KPITCH + 16 * kk + 8 * h) * 2);                                        \
                const bf16x8 a1 = *(const LAS bf16x8*)(ks + ((32 + r) * KPITCH + 16 * kk + 8 * h) * 2);                                 \
                s0 = MFMA32(a0, qf[kk], s0); s1 = MFMA32(a1, qf[kk], s1);                                                               \
            }                                                                                                                           \
            if (KIND == 3) {                                                                                                            \
                const bool diag = (k0 + 63 >= qlo);                                                                                     \
                stick_block(s1, Rr, t, k0 + 32, h, diag);                                                                               \
                stick_block(s0, Rr, t, k0, h, diag);                                                                                    \
            } else {                                                                                                                    \
                softmax_tile<KIND>(s0, s1, l, t, k0, h, qlo, lut, cb, W, dmask, rowshift);                                              \
            }                                                                                                                           \
            _Pragma("unroll") for (int st = 0; st < 2; ++st) {                                                                          \
                const bf16x8 pb = pack8(s0, st);                                                                                        \
                _Pragma("unroll") for (int db = 0; db < DV / 32; ++db) o[db] = MFMA32(vfrag<DV>(vt, 32 * db, 16 * st + 4 * h, lane), pb, o[db]);      \
            }                                                                                                                           \
            _Pragma("unroll") for (int st = 0; st < 2; ++st) {                                                                          \
                const bf16x8 pb = pack8(s1, st);                                                                                        \
                _Pragma("unroll") for (int db = 0; db < DV / 32; ++db) o[db] = MFMA32(vfrag<DV>(vt, 32 * db, 32 + 16 * st + 4 * h, lane), pb, o[db]); \
            }                                                                                                                           \
        }                                                                                                                               \
        if (tt - 1 >= t_lo) tile_store<DV>(TCUR, L + (buf ? AL_KS0 : AL_KS1), L + (buf ? AL_VT0 : AL_VT1), tid);                        \
        buf ^= 1;                                                                                                                       \
    }
    for (int tt = t_hi; tt >= t_lo; tt -= 2) {
        ATTN_STEP(TA, TB)
        if (tt - 1 < t_lo) break;
        { const int tt_save = tt; (void)tt_save; }
        tt -= 1;
        ATTN_STEP(TB, TA)
        tt += 1;
    }
#undef ATTN_STEP
}

__device__ __forceinline__ void qk_tile(LAS unsigned char* ks, const bf16x8 (&qf)[4], int r, int h, f32x16& s0, f32x16& s1) {
    bf16x8 kf[8];
#pragma unroll
    for (int kk = 0; kk < 4; ++kk) {
        kf[2 * kk]     = *(const LAS bf16x8*)(ks + (r * KPITCH + 16 * kk + 8 * h) * 2);
        kf[2 * kk + 1] = *(const LAS bf16x8*)(ks + ((32 + r) * KPITCH + 16 * kk + 8 * h) * 2);
    }
#pragma unroll
    for (int i = 0; i < 16; ++i) { s0[i] = 0.f; s1[i] = 0.f; }
#pragma unroll
    for (int kk = 0; kk < 4; ++kk) { s0 = MFMA32(kf[2 * kk], qf[kk], s0); s1 = MFMA32(kf[2 * kk + 1], qf[kk], s1); }
}
__device__ __forceinline__ void pv_tile(LAS unsigned char* vt, const f32x16& s0, const f32x16& s1, int h, int lane, f32x16 (&o)[2]) {
#pragma unroll
    for (int st = 0; st < 2; ++st) {
        const bf16x8 pb = pack8(s0, st);
#pragma unroll
        for (int db = 0; db < 2; ++db) o[db] = MFMA32(vfrag<64>(vt, 32 * db, 16 * st + 4 * h, lane), pb, o[db]);
    }
#pragma unroll
    for (int st = 0; st < 2; ++st) {
        const bf16x8 pb = pack8(s1, st);
#pragma unroll
        for (int db = 0; db < 2; ++db) o[db] = MFMA32(vfrag<64>(vt, 32 * db, 32 + 16 * st + 4 * h, lane), pb, o[db]);
    }
}
template <int KIND  >
__device__ __forceinline__ void score_tile(f32x16& s0, f32x16& s1, float& l, float& Rr, int t, int k0, int h, int qlo, const LAS float* lut, const LAS float* cb, int W, int dmask, float rowshift) {
    if (KIND == 3) { const bool diag = (k0 + 63 >= qlo); stick_block(s1, Rr, t, k0 + 32, h, diag); stick_block(s0, Rr, t, k0, h, diag); }
    else softmax_tile<KIND>(s0, s1, l, t, k0, h, qlo, lut, cb, W, dmask, rowshift);
}

template <int KIND  >
__device__ __forceinline__ void attn_pass2(LAS unsigned char* L, const bf16* Qp, int qpitch, const bf16* Kp, int kpitch, const bf16* Vp, int vpitch,
                                           int q0w, int t_lo, int t_hi, f32x16 (&o)[2], const float bnd, float& l, float& Rr,
                                           const LAS float* lut, const LAS float* cb, int W, int dmask, const int tid, const bool wave_on = true) {
    const int lane = tid & 63, r = lane & 31, h = lane >> 5;
    const int t = q0w + r, qlo = q0w, qhi = wave_on ? q0w + 31 : -1;
    bf16x8 qf[4];
#pragma unroll
    for (int ks = 0; ks < 4; ++ks) qf[ks] = *(const bf16x8*)(Qp + (unsigned)((wave_on ? t : 0) * qpitch + 16 * ks + 8 * h));
    TileRegs<64> TA, TB;
    __syncthreads();
    tile_load<64>(TA, Kp, kpitch, Vp, vpitch, t_hi * 64, tid);
    if (t_hi - 1 >= t_lo) tile_load<64>(TB, Kp, kpitch, Vp, vpitch, (t_hi - 1) * 64, tid);
    tile_store<64>(TA, L + 0, L + 36864, tid);
    if (t_hi - 1 >= t_lo) tile_store<64>(TB, L + 9216, L + 36864 + 9216, tid);
    if (t_hi - 2 >= t_lo) tile_load<64>(TA, Kp, kpitch, Vp, vpitch, (t_hi - 2) * 64, tid);
    if (t_hi - 3 >= t_lo) tile_load<64>(TB, Kp, kpitch, Vp, vpitch, (t_hi - 3) * 64, tid);
    float rowshift = 0.f;
    if (KIND == 1) rowshift = -cb[t] - bnd;
    volatile LAS int* dflag = (volatile LAS int*)(L + AL_ITEM + 32);
    const int wv = tid >> 6;
    if (KIND == 3 && lane == 0) { dflag[wv] = 0; dflag[8 + wv] = 0; }
    bool wdone = false; int it = 0;
    int par = 0;
    for (int tt = t_hi; tt >= t_lo; tt -= 2, ++it) {
        __syncthreads();
        if (KIND == 3) {
            const int rb = ((it + 1) & 1) * 8;
            const int alld = dflag[rb] & dflag[rb + 1] & dflag[rb + 2] & dflag[rb + 3] & dflag[rb + 4] & dflag[rb + 5] & dflag[rb + 6] & dflag[rb + 7];
            if (alld) break;
        }
        const int k0a = tt * 64, k0b = k0a - 64;
        bool actA = (k0a <= qhi), actB = (tt - 1 >= t_lo) && (k0b <= qhi);
        if (KIND == 2) { actA = actA && (k0a + 63 >= qlo - W); actB = actB && (k0b + 63 >= qlo - W); }
        if (KIND == 3) { actA = actA && !wdone; actB = actB && !wdone; }
        if (KIND == 1) {
            actA = actA && (cb[k0a + 63] - cb[qlo] >= -152.0f); actB = actB && (k0b >= 0) && (cb[max(k0b, 0) + 63] - cb[qlo] >= -152.0f); }
        LAS unsigned char* ksA = L + par * 9216;       LAS unsigned char* vtA = L + 36864 + par * 9216;
        LAS unsigned char* ksB = L + (par + 1) * 9216; LAS unsigned char* vtB = L + 36864 + (par + 1) * 9216;
        if (actA && actB) {
            f32x16 a0, a1, b0, b1;
            qk_tile(ksA, qf, r, h, a0, a1);
            qk_tile(ksB, qf, r, h, b0, b1);
            score_tile<KIND>(a0, a1, l, Rr, t, k0a, h, qlo, lut, cb, W, dmask, rowshift);
            pv_tile(vtA, a0, a1, h, lane, o);
            score_tile<KIND>(b0, b1, l, Rr, t, k0b, h, qlo, lut, cb, W, dmask, rowshift);
            pv_tile(vtB, b0, b1, h, lane, o);
        } else if (actA) {
            f32x16 a0, a1;
            qk_tile(ksA, qf, r, h, a0, a1);
            score_tile<KIND>(a0, a1, l, Rr, t, k0a, h, qlo, lut, cb, W, dmask, rowshift);
            pv_tile(vtA, a0, a1, h, lane, o);
        } else if (actB) {
            f32x16 b0, b1;
            qk_tile(ksB, qf, r, h, b0, b1);
            score_tile<KIND>(b0, b1, l, Rr, t, k0b, h, qlo, lut, cb, W, dmask, rowshift);
            pv_tile(vtB, b0, b1, h, lane, o);
        }
        if (KIND == 3) {
            wdone = wdone || (wave_on ? (__all(Rr < -152.0f) != 0) : true);
            if (lane == 0) dflag[(it & 1) * 8 + wv] = wdone ? 1 : 0;
        }
        const int np = par ^ 2;
        if (tt - 2 >= t_lo) tile_store<64>(TA, L + np * 9216, L + 36864 + np * 9216, tid);
        if (tt - 3 >= t_lo) tile_store<64>(TB, L + (np + 1) * 9216, L + 36864 + (np + 1) * 9216, tid);
        if (tt - 4 >= t_lo) tile_load<64>(TA, Kp, kpitch, Vp, vpitch, (tt - 4) * 64, tid);
        if (tt - 5 >= t_lo) tile_load<64>(TB, Kp, kpitch, Vp, vpitch, (tt - 5) * 64, tid);
        par = np;
    }
}

template <int NB> __device__ __forceinline__ void zero_o(f32x16 (&o)[NB]) {
#pragma unroll
    for (int b = 0; b < NB; ++b)
#pragma unroll
        for (int i = 0; i < 16; ++i) o[b][i] = 0.f;
}
__device__ __forceinline__ void store_o64(const f32x16 (&o)[2], float inv, bf16* orow, int h) {
#pragma unroll
    for (int db = 0; db < 2; ++db)
#pragma unroll
        for (int c = 0; c < 4; ++c) {
            v2u w; w.x = pk2(o[db][4 * c] * inv, o[db][4 * c + 1] * inv); w.y = pk2(o[db][4 * c + 2] * inv, o[db][4 * c + 3] * inv);
            *(v2u*)(orow + 32 * db + 8 * c + 4 * h) = w;
        }
}

constexpr int N_ABC_ITEMS = 8 * 256, N_ATT_ITEMS = N_ABC_ITEMS + 1024;
constexpr size_t DP_O = 0, DP_L = (size_t)48 << 20;

__device__ __forceinline__ void attention_phase(PPtr p, int layer, LAS unsigned char* L, unsigned* counter, const bool do_store) {
    const int tid = opaque_tid(), lane = tid & 63, wave = tid >> 6, r = lane & 31, h = lane >> 5;
    unsigned char* big = p->ws + WS_BIG;
    LAS float* lut = (LAS float*)(L + AL_LUT);
    LAS float* cb = (LAS float*)(L + AL_CB);
    LAS float* scan = (LAS float*)(L + AL_SCAN);
    volatile LAS unsigned* itemw = (volatile LAS unsigned*)(L + AL_ITEM);
    const float* rel = p->in[1];
    for (;;) {
        __syncthreads();
        if (tid == 0) itemw[0] = atomicAdd(counter, 1u);
        __syncthreads();
        const int idx = (int)itemw[0];
        if (idx >= N_ATT_ITEMS) break;
        int tl_ = tid; asm volatile("" : "+v"(tl_));
        const int lane = tl_ & 63, r = lane & 31, h = lane >> 5;
        int qb, rr, dsel = 0;
        if (idx < N_ABC_ITEMS) { qb = 7 - (idx >> 8); rr = idx & 255; }
        else { dsel = idx - N_ABC_ITEMS; qb = 0; rr = 256; }
#ifdef PROBE_ATT_TYPE
        if (!do_store) { const int ty = (rr < 64) ? 0 : (rr < 160 ? 1 : (rr < 256 ? 2 : 3)); if (ty != PROBE_ATT_TYPE) continue; }
#endif
        const int q0blk = qb * 256, q0w = q0blk + 32 * wave;
        const int t_hi = (q0blk + 255) >> 6;
        float dummyR = 0.f;
        if (rr < 64) {
            const int b = rr >> 2, hd = rr & 3;
            float bnd;
            {
                float mq = fabsf(p->in[9][layer * 64 + lane]), mk = fabsf(p->in[10][layer * 64 + lane]), mb = (lane < 32) ? fabsf(rel[lane * 10 + hd]) : 0.f;
#pragma unroll
                for (int o_ = 1; o_ < 64; o_ <<= 1) { mq = fmaxf(mq, __shfl_xor(mq, o_)); mk = fmaxf(mk, __shfl_xor(mk, o_)); mb = fmaxf(mb, __shfl_xor(mb, o_)); }
                bnd = 64.f * mq * mk * QSCALE * 1.02f + mb * LOG2E + 0.5f;
            }
            if (tid <= 128) lut[tid] = rel[rel_bucket(tid) * 10 + hd] * LOG2E - bnd;
            const float* lv = p->in[11] + (size_t)layer * 256;
            const float lam = expf(wave_sum(lv[lane] * lv[64 + lane])) - expf(wave_sum(lv[128 + lane] * lv[192 + lane])) + p->lam_init[layer];
            const size_t rowb = (size_t)b * S;
            bf16* QA = (bf16*)(big + B_QA) + rowb * 512 + hd * 128;
            const bf16* KA = (const bf16*)(big + B_KA) + rowb * 512 + hd * 128;
            const bf16* VA = (const bf16*)(big + B_VA) + rowb * 512 + hd * 128;
            LAS unsigned* o0p = (LAS unsigned*)(L + AL_O0) + tid;
            f32x16 o[4]; float l;
            zero_o<4>(o); l = 0.f;
            attn_pass<0, 128>(L, QA, 512, KA, 512, VA, 512, q0w, 0, t_hi, o, bnd, l, dummyR, lut, cb, 0, 0, tid);
            { const float inv = 1.0f / (l + __shfl_xor(l, 32));
#pragma unroll
              for (int db = 0; db < 4; ++db)
#pragma unroll
                  for (int i = 0; i < 8; ++i) o0p[(db * 8 + i) * NTHREADS] = pk2(o[db][2 * i] * inv, o[db][2 * i + 1] * inv); }
            zero_o<4>(o); l = 0.f;
            attn_pass<0, 128>(L, QA + 64, 512, KA + 64, 512, VA, 512, q0w, 0, t_hi, o, bnd, l, dummyR, lut, cb, 0, 0, tid);
            { const float inv = lam / (l + __shfl_xor(l, 32));
              float ss = 0.f;
#pragma unroll
              for (int db = 0; db < 4; ++db)
#pragma unroll
                  for (int i = 0; i < 8; ++i) {
                      const unsigned w0 = o0p[(db * 8 + i) * NTHREADS];
                      const float a = bflo(w0) - o[db][2 * i] * inv, c = bfhi(w0) - o[db][2 * i + 1] * inv;
                      o[db][2 * i] = a; o[db][2 * i + 1] = c; ss += a * a + c * c;
                  }
              ss += __shfl_xor(ss, 32);
              const float rs = rsqrtf(ss * (1.0f / 128.0f) + RMS_EPS) * p->one_minus_lam_init[layer];
              const float* sg = p->in[12] + (size_t)layer * 128;
              bf16* orow = QA + (size_t)(q0w + r) * 512;
              if (do_store)
#pragma unroll
              for (int db = 0; db < 4; ++db)
#pragma unroll
                  for (int c = 0; c < 4; ++c) {
                      const int dv = 32 * db + 8 * c + 4 * h;
                      const f32x4 g4 = *(const f32x4*)(sg + dv);
                      v2u w; w.x = pk2(o[db][4 * c] * rs * g4[0], o[db][4 * c + 1] * rs * g4[1]); w.y = pk2(o[db][4 * c + 2] * rs * g4[2], o[db][4 * c + 3] * rs * g4[3]);
                      *(v2u*)(orow + dv) = w;
                  }
            }
        } else if (rr < 160) {
            const int q = rr - 64, b = q / 6, hd = q % 6;
            const size_t rowb = (size_t)b * S;
            bf16* QB = (bf16*)(big + B_QB) + rowb * 384 + hd * 64;
            const bf16* KB = (const bf16*)(big + B_KB) + rowb * 384 + hd * 64;
            const bf16* VB = (const bf16*)(big + B_VB) + rowb * 384 + hd * 64;
            f32x16 o[2]; float l = 0.f, Rr = 0.f;
            zero_o<2>(o);
            attn_pass2<3>(L, QB, 384, KB, 384, VB, 384, q0w, 0, t_hi, o, 0.f, l, Rr, lut, cb, 0, 0, tid);
            if (do_store) store_o64(o, 1.0f, QB + (size_t)(q0w + r) * 384, h);
        } else if (rr < 256) {
            const int q = rr - 160, b = q / 6, hd = q % 6;
            const size_t rowb = (size_t)b * S;
            {
                const int qend = q0blk + 256;
                const float* lf = (const float*)(p->ws + WS_LOGF) + rowb * 8 + hd;
                int tq = tid; asm volatile("" : "+v"(tq));
                float v[4];
#pragma unroll
                for (int i = 0; i < 4; ++i) { const int tok = 4 * tq + i; v[i] = (tok < qend) ? lf[(size_t)tok * 8] : 0.f; }
                v[1] += v[0]; v[2] += v[1]; v[3] += v[2];
                float incl = v[3];
#pragma unroll
                for (int off = 1; off < 64; off <<= 1) { const float y = __shfl_up(incl, off); if (lane >= off) incl += y; }
                if (lane == 63) scan[wave] = incl;
                __syncthreads();
                float pre = incl - v[3];
                for (int w2 = 0; w2 < wave; ++w2) pre += scan[w2];
#pragma unroll
                for (int i = 0; i < 4; ++i) cb[4 * tid + i] = -(pre + v[i]) * LOG2E;
            }
            bf16* QC = (bf16*)(big + B_QC) + rowb * 384 + hd * 64;
            const bf16* KC = (const bf16*)(big + B_KC) + rowb * 384 + hd * 64;
            const bf16* VC = (const bf16*)(big + B_VC) + rowb * 384 + hd * 64;
            float bnd;
            {   float mq = fabsf(p->in[13][layer * 64 + lane]), mk = fabsf(p->in[14][layer * 64 + lane]);
#pragma unroll
                for (int o_ = 1; o_ < 64; o_ <<= 1) { mq = fmaxf(mq, __shfl_xor(mq, o_)); mk = fmaxf(mk, __shfl_xor(mk, o_)); }
                bnd = 64.f * mq * mk * QSCALE * 1.02f + 0.5f; }
            f32x16 o[2]; float l = 0.f;
            zero_o<2>(o);
            __syncthreads();
            int tlc = 0;
            while (tlc < t_hi && (cb[64 * tlc + 63] - cb[q0blk] < -152.0f)) ++tlc;
            attn_pass2<1>(L, QC, 384, KC, 384, VC, 384, q0w, tlc, t_hi, o, bnd, l, dummyR, lut, cb, 0, 0, tid);
            const float inv = 1.0f / (l + __shfl_xor(l, 32));
            if (do_store) store_o64(o, inv, QC + (size_t)(q0w + r) * 384, h);
        } else {
            int g, dd, rho, q0v, bh;
            if (dsel < 256)      { g = 0; dd = 1;  bh = dsel & 31; rho = 0; q0v = (7 - (dsel >> 5)) * 256; }
            else if (dsel < 512) { const int j = dsel - 256; g = 1; dd = 4; bh = j & 31; rho = (j >> 5) & 3; q0v = (1 - (j >> 7)) * 256; }
            else                 { const int j = dsel - 512; g = 2; dd = 16; bh = j & 31; rho = j >> 5; q0v = 0; }
            const int b = bh >> 1, hs = bh & 1, Sv = S / dd;
            const size_t rowb = (size_t)b * S;
            float bnd;
            {   float mq = fabsf(p->in[15][layer * 64 + lane]), mk = fabsf(p->in[16][layer * 64 + lane]);
                float mb = (lane < 32) ? fmaxf(fmaxf(fabsf(rel[lane * 10 + 4 + hs]), fabsf(rel[lane * 10 + 6 + hs])), fabsf(rel[lane * 10 + 8 + hs])) : 0.f;
#pragma unroll
                for (int o_ = 1; o_ < 64; o_ <<= 1) { mq = fmaxf(mq, __shfl_xor(mq, o_)); mk = fmaxf(mk, __shfl_xor(mk, o_)); mb = fmaxf(mb, __shfl_xor(mb, o_)); }
                bnd = 64.f * mq * mk * QSCALE * 1.02f + mb * LOG2E + 0.5f; }
            if (tid <= 128) lut[tid] = rel[rel_bucket(min(dd * tid, 2047)) * 10 + 4 + 2 * g + hs] * LOG2E - bnd;
            const int col = (2 * g + hs) * 64;
            const bf16* QD = (const bf16*)(big + B_QD) + (rowb + rho) * 384 + col;
            const bf16* KD = (const bf16*)(big + B_KD) + (rowb + rho) * 384 + col;
            const bf16* VD = (const bf16*)(big + B_VD) + (rowb + rho) * 384 + col;
            const int q0wv = q0v + 32 * wave;
            const bool won = q0wv < Sv;
            const int thv = (min(q0v + 255, Sv - 1)) >> 6, tlv = max(0, q0v - 128) >> 6;
            f32x16 o[2]; float l = 0.f;
            zero_o<2>(o);
            attn_pass<2, 64>(L, QD, 384 * dd, KD, 384 * dd, VD, 384 * dd, q0wv, tlv, thv, o, bnd, l, dummyR, lut, cb, 128, 0, tid, won);
            const float lt = l + __shfl_xor(l, 32);
            if (won && do_store) {
                const size_t tok = rowb + rho + (size_t)dd * (q0wv + r);
                float* po = (float*)((unsigned char*)p->out + DP_O) + ((size_t)g * M + tok) * 128 + hs * 64;
#pragma unroll
                for (int db = 0; db < 2; ++db)
#pragma unroll
                    for (int c = 0; c < 4; ++c) *(f32x4*)(po + 32 * db + 8 * c + 4 * h) = (f32x4){o[db][4 * c], o[db][4 * c + 1], o[db][4 * c + 2], o[db][4 * c + 3]};
                if (h == 0) ((float*)((unsigned char*)p->out + DP_L))[((size_t)g * M + tok) * 2 + hs] = lt;
            }
        }
    }
}

__device__ __forceinline__ void dcombine_phase(float* dout, bf16* od) {
    const int tid = opaque_tid();
    const float* PO = (const float*)((unsigned char*)dout + DP_O); const float* PL = (const float*)((unsigned char*)dout + DP_L);
    for (int u = blockIdx.x * NTHREADS + tid; u < M * 32; u += gridDim.x * NTHREADS) {
        const int tok = u >> 5, c0 = (u & 31) * 8;
        v4u w = {0u, 0u, 0u, 0u};
        if (c0 < 128) {
            const int hs = c0 >> 6;
            f32x4 a = {0.f, 0.f, 0.f, 0.f}, bq = a; float lsum = 0.f;
#pragma unroll
            for (int g = 0; g < 3; ++g) {
                const float* q = PO + ((size_t)g * M + tok) * 128 + c0;
                a = a + *(const f32x4*)q; bq = bq + *(const f32x4*)(q + 4);
                lsum += PL[((size_t)g * M + tok) * 2 + hs];
            }
            const float inv = 1.0f / lsum;
            w.x = pk2(a[0] * inv, a[1] * inv); w.y = pk2(a[2] * inv, a[3] * inv); w.z = pk2(bq[0] * inv, bq[1] * inv); w.w = pk2(bq[2] * inv, bq[3] * inv);
        }
        *(v4u*)(od + (size_t)tok * 256 + c0) = w;
    }
}

#define XB_TMO      128
#define XB_XCNT(j)  (256  + 64 * (j))
#define XB_XSUB(j)  (1280 + 64 * (j))
#define XB_XGEN(j)  (2304 + 64 * (j))
#define XB_TOP      3328
#define XB_TOPGEN   3392
#define XCD_BAR_WORDS 3456
#define XB_SPIN_CAP (1u << 18)

__device__ __forceinline__ unsigned xb_ld(unsigned* p)              { return __hip_atomic_load(p, __ATOMIC_RELAXED, __HIP_MEMORY_SCOPE_AGENT); }
__device__ __forceinline__ unsigned xb_add(unsigned* p, unsigned v) { return __hip_atomic_fetch_add(p, v, __ATOMIC_RELAXED, __HIP_MEMORY_SCOPE_AGENT); }
__device__ __forceinline__ unsigned xb_xcc_id() { return (unsigned)__builtin_amdgcn_s_getreg((3 << 11) | 20) & 0xFu; }
#define XB_SPIN(cond, bar) do { unsigned _sp = 0; while (cond) { __builtin_amdgcn_s_sleep(1); \
    if ((++_sp & 255u) == 0u) { if (xb_ld(&(bar)[XB_TMO])) break; if (_sp > XB_SPIN_CAP) { atomicAdd(&(bar)[XB_TMO], 1u); break; } } } } while (0)

struct XcdBarrier {
    unsigned* bar; unsigned x;
    volatile LAS unsigned* st;
};

__device__ __forceinline__ XcdBarrier xcd_barrier_post(unsigned* bar, volatile LAS unsigned* st) {
    XcdBarrier b; b.bar = bar; b.x = xb_xcc_id(); b.st = st;
    if (threadIdx.x == 0) (void)xb_add(&bar[XB_XCNT(b.x)], 1u);
    return b;
}
__device__ __forceinline__ void xcd_barrier_complete(unsigned* bar, unsigned x, unsigned& nloc, unsigned& nx) {
    const unsigned G = gridDim.x * gridDim.y * gridDim.z;
    unsigned sum, cnt, mine, sp = 0u;
    for (;;) {
        sum = 0u; cnt = 0u; mine = 0u;
#pragma unroll
        for (unsigned j = 0; j < 16; ++j) { const unsigned c = xb_ld(&bar[XB_XCNT(j)]); sum += c; cnt += (c > 0u) ? 1u : 0u; mine = (j == x) ? c : mine; }
        if (sum == G) break;
        __builtin_amdgcn_s_sleep(1);
        if ((++sp & 255u) == 0u) { if (xb_ld(&bar[XB_TMO])) break; if (sp > XB_SPIN_CAP) { atomicAdd(&bar[XB_TMO], 1u); break; } }
    }
    nloc = mine > 0u ? mine : 1u; nx = cnt > 0u ? cnt : 1u;
}

__device__ __forceinline__ void xcd_barrier(const XcdBarrier& b) {
    asm volatile("s_waitcnt vmcnt(0)" ::: "memory");
    __syncthreads();
    if (threadIdx.x == 0) {
        unsigned* bar = b.bar;
        __builtin_amdgcn_s_waitcnt(0);
        unsigned nloc = b.st[0], nx = b.st[1];
        if (nloc == 0u) { xcd_barrier_complete(bar, b.x, nloc, nx); b.st[0] = nloc; b.st[1] = nx; }
        const unsigned old = xb_add(&bar[XB_XSUB(b.x)], 1u);
        const unsigned gen = old / nloc;
        if (old + 1u == (gen + 1u) * nloc) {
            __builtin_amdgcn_fence(__ATOMIC_RELEASE, "agent");
            asm volatile("s_waitcnt vmcnt(0)" ::: "memory");
            const unsigned og = xb_add(&bar[XB_TOP], 1u);
            const unsigned tg = og / nx;
            if (og + 1u == (tg + 1u) * nx) xb_add(&bar[XB_TOPGEN], 1u);
            else XB_SPIN(xb_ld(&bar[XB_TOPGEN]) == tg, bar);
            __builtin_amdgcn_fence(__ATOMIC_ACQUIRE, "agent");
            xb_add(&bar[XB_XGEN(b.x)], 1u);
            asm volatile("s_waitcnt vmcnt(0)" ::: "memory");
        } else {
            XB_SPIN(xb_ld(&bar[XB_XGEN(b.x)]) == gen, bar);
            __builtin_amdgcn_fence(__ATOMIC_ACQUIRE, "agent");
            asm volatile("s_waitcnt vmcnt(0)" ::: "memory");
        }
    }
    __syncthreads();
}

struct EpiAny {
    static constexpr bool PERM = true, AFTER_DRAIN = false;
    PPtr pp; LAS unsigned char* lds; int kind, layer, bi; float* outf; float scale; const float* rss_in; float* rss_out;
    __device__ __forceinline__ void operator()(AccRef acc, const pg8::Unit& u, int wr, int wc, int fr, int fq) const {
        asm volatile("" : "+v"(fr), "+v"(fq));
        unsigned char* ws = pp->ws; unsigned char* big = ws + WS_BIG;
        LAS float* rst = (LAS float*)(lds + 131072 + 256);
        if (kind == 0 || kind == 2 || kind == 4) {
            const int t = opaque_tid();
            if (t < 256) rst[t] = row_rs(rss_in, u.pm * 256 + t);
            __syncthreads();
        }
        if (kind == 0) { EpiSwiglu E{(bf16*)big, rst}; E(acc, u, wr, wc, fr, fq); }
        else if (kind == 1) { EpiResid E{(bf16*)(ws + WS_HN), outf, scale, rss_out}; E(acc, u, wr, wc, fr, fq); }
        else if (kind == 2) {
            const int l = layer;
            EpiQKV E{big, pp->in[9] + l * 64, pp->in[10] + l * 64, pp->in[13] + l * 64, pp->in[14] + l * 64, pp->in[15] + l * 64, pp->in[16] + l * 64, pp->in[8] + l * 6, (float*)(ws + WS_LOGF), rst};
            E(acc, u, wr, wc, fr, fq);
        }
        else if (kind == 3) { EpiPStore E{(v4u*)(big + B_P)}; E(acc, u, wr, wc, fr, fq); }
        else { EpiGate E{pp->in[7] + (size_t)layer * 4 * D + (size_t)bi * D, (const v4u*)(big + B_P), (v4u*)(big + B_TMP), (bf16*)(big + B_MRG), bi == 0, bi == 3, rst}; E(acc, u, wr, wc, fr, fq); }
    }
};

constexpr int STEPS_PER_LAYER = 16, CW_BAR = 4096;
#ifndef PROBE_STEP
#define PROBE_STEP (-1)
#endif
#ifndef PROBE_SYNCS
#define PROBE_SYNCS 0
#endif
__global__ void __launch_bounds__(NTHREADS, 2) mega_fwd(Params p) {
    extern __shared__ __attribute__((aligned(16))) unsigned char lds_raw[];
    LAS unsigned char* lds = (LAS unsigned char*)lds_raw;
    cg::grid_group grid = cg::this_grid();

    if (blockIdx.x == 0) for (int i = threadIdx.x; i < CW_BAR + XCD_BAR_WORDS; i += NTHREADS) ((unsigned*)(p.ws + WS_CTL))[i] = 0u;
    volatile LAS unsigned* bst = (volatile LAS unsigned*)(lds + LDS_BST);
    if (threadIdx.x < 2) bst[threadIdx.x] = 0u;
    prologue_weights(p, lds);
#ifdef PROBE_PROLOGUE
    prologue_weights(p, lds);
#endif
    norm_phase(p.in[0], (bf16*)(p.ws + WS_HN), (float*)(p.ws + WS_RSP));
    grid.sync();
    (void)xcd_barrier_post((unsigned*)(p.ws + WS_CTL) + CW_BAR, bst);

    constexpr int SPL = STEPS_PER_LAYER + ((PROBE_STEP >= 0) ? 1 : 0);
#pragma unroll 1
    for (int step = 0; step < 2 * SPL; ++step) {
        const int l = step / SPL; int k = step % SPL; bool dry = false;
        if (PROBE_STEP >= 0) { if (k == PROBE_STEP) dry = true; else if (k > PROBE_STEP) k -= 1; }
        PPtr pp = (PPtr)__builtin_amdgcn_kernarg_segment_ptr(); asm volatile("" : "+s"(pp));
        unsigned char* ws = pp->ws;
        unsigned char* wb = ws + WS_W + (size_t)l * W_LAYER;
        unsigned char* big = ws + WS_BIG;
        bf16* HN = (bf16*)(ws + WS_HN);
        float* xres = pp->out;
        float* rssb = (float*)(ws + WS_RSP);
        bool is_att = false, is_comb = false, sync_after = true;
        const bf16* A = HN; const bf16* Bt = (const bf16*)wb; int N = D, K = D;
        EpiAny E; E.pp = pp; E.lds = lds; E.kind = 1; E.layer = l; E.bi = 0; E.outf = nullptr; E.scale = 1.0f; E.rss_in = rssb; E.rss_out = rssb;
        if (k == 0)       { A = HN; Bt = (const bf16*)(wb + W_1T); N = 2 * FF; K = D; E.kind = 0; E.rss_in = rssb; }
        else if (k == 1)  { A = (const bf16*)big; Bt = (const bf16*)(wb + W_2T); N = D; K = FF; E.kind = 1; E.scale = 0.5f; }
        else if (k == 2)  { A = HN; Bt = (const bf16*)(wb + W_INT); N = NQKV; K = D; E.kind = 2; E.rss_in = rssb; }
        else if (k == 3)  { is_att = true; }
        else if (k == 4)  { is_comb = true; }
        else if (k < 13)  {
            const int i = (k - 5) >> 1;
            E.bi = i;
            if (((k - 5) & 1) == 0) {
                const size_t aoff = (i == 0) ? B_QA : (i == 1 ? B_QB : (i == 2 ? B_QC : B_OD));
                const size_t woff = (i == 0) ? WB_A : (i == 1 ? WB_B : (i == 2 ? WB_C : WB_D));
                A = (const bf16*)(big + aoff); Bt = (const bf16*)(wb + W_BRT + woff); N = D; K = (i == 0) ? 512 : (i == 3 ? 256 : 384); E.kind = 3;
            } else {
                A = HN; Bt = (const bf16*)(wb + W_GT) + (size_t)i * D * D; N = D; K = D; E.kind = 4; E.rss_in = rssb;
            }
            sync_after = (k == 12);
        }
        else if (k == 13) { A = (const bf16*)(big + B_MRG); Bt = (const bf16*)(wb + W_OT); N = D; K = D; E.kind = 1; E.scale = 1.0f; }
        else if (k == 14) { A = HN; Bt = (const bf16*)(wb + W_3T); N = 2 * FF; K = D; E.kind = 0; E.rss_in = rssb; }
        else              { A = (const bf16*)big; Bt = (const bf16*)(wb + W_4T); N = D; K = FF; E.kind = 1; E.scale = 0.5f; if (l == 1) E.outf = xres; }

        if (is_comb) {
            dcombine_phase(xres, (bf16*)(big + B_OD));
        } else if (!is_att) {
            if (dry && E.kind == 1) { E.scale = 0.f; E.outf = nullptr; }
            pg8::Gemm g{A, Bt, M, N, K}; pg8::StaticOrder So; So.init(M, N, (int)gridDim.x, (int)blockIdx.x);
            pg8::gemm_phase<EpiAny, pg8::StaticOrder, true, true>(lds, g, So, E);
        } else {
            attention_phase(pp, l, lds, (unsigned*)(ws + WS_CTL) + l + (dry ? 2 : 0), !dry);
        }
        if (step == 2 * SPL - 1) sync_after = false;
        if (dry || sync_after) {
            XcdBarrier xb; xb.bar = (unsigned*)(ws + WS_CTL) + CW_BAR; xb.x = xb_xcc_id(); xb.st = (volatile LAS unsigned*)(lds + LDS_BST);
            int nb = 1;
            if (PROBE_SYNCS > 0 && k == 0) nb += PROBE_SYNCS;
#pragma unroll 1
            for (int i = 0; i < nb; ++i) xcd_barrier(xb);
        }
    }
}

extern "C" void kernel_launch(void* const* d_in, const int* in_sizes, int n_in, void* d_out, int out_size, void* d_ws, size_t ws_size, hipStream_t stream) {
    static int grid = 0;
    if (grid == 0) {
        if (n_in != 22 || out_size != M * D || ws_size < WS_END) { fprintf(stderr, "kernel_launch: unexpected shapes (n_in %d, out %d, ws %zu)\n", n_in, out_size, ws_size); grid = -1; return; }
        int dev = 0, cus = 0, per_cu = 0;
        hipGetDevice(&dev);
        hipDeviceGetAttribute(&cus, hipDeviceAttributeMultiprocessorCount, dev);
        if (hipFuncSetAttribute((const void*)mega_fwd, hipFuncAttributeMaxDynamicSharedMemorySize, LDS_BYTES) != hipSuccess) fprintf(stderr, "kernel_launch: hipFuncSetAttribute failed\n");
        if (hipOccupancyMaxActiveBlocksPerMultiprocessor(&per_cu, (const void*)mega_fwd, NTHREADS, LDS_BYTES) != hipSuccess || per_cu < 1) per_cu = 1;
        (void)hipGetLastError();
        grid = cus * per_cu;
    }
    if (grid < 0) return;
    Params p{};
    for (int i = 0; i < 22; ++i) p.in[i] = (const float*)d_in[i];
    p.out = (float*)d_out; p.ws = (unsigned char*)d_ws;
    for (int l = 0; l < 2; ++l) { const double li = 0.8 - 0.6 * exp(-0.3 * (double)l); p.lam_init[l] = (float)li; p.one_minus_lam_init[l] = (float)(1.0 - li); }
    void* args[] = {&p};
    hipError_t e = hipLaunchCooperativeKernel((const void*)mega_fwd, dim3(grid), dim3(NTHREADS), args, LDS_BYTES, stream);
    if (e != hipSuccess) fprintf(stderr, "cooperative launch failed: %s (grid %d)\n", hipGetErrorString(e), grid);
}
```

```cpp
#include <hip/hip_runtime.h>
#include <hip/hip_cooperative_groups.h>
#include <cstdio>
#include <cstdint>
#include <cmath>
namespace cg = cooperative_groups;
namespace pg8 {
#define PG8_LAS __attribute__((address_space(3)))
typedef unsigned short bf16_t;
typedef short bf16x8 __attribute__((ext_vector_type(8)));
typedef float f32x4 __attribute__((ext_vector_type(4)));
typedef unsigned u32x4 __attribute__((ext_vector_type(4)));
constexpr int BM = 256, BK = 64, HALF = 128, HTB = HALF * BK * 2  , STAGE_BYTES = 8 * HTB, NXCD = 8, WGM = 8;

__host__ __device__ __forceinline__ int lds_byte(int r, int c) { const int st = (r >> 4) * 2 + (c >> 5), rr = r & 15, cc = c & 31, ob = rr * 64 + cc * 2; return st * 1024 + (ob ^ (((ob >> 9) & 1) << 5)); }
__host__ __device__ __forceinline__ void stage_rc(int b, int& R, int& C) { const int st = b / 1024, sb = b % 1024, swz = sb ^ (((sb >> 9) & 1) << 5); R = (st >> 1) * 16 + swz / 64; C = (st & 1) * 32 + (swz % 64) / 2; }
__host__ __device__ __forceinline__ int perm32(int rho) { const int n = rho >> 4, i = rho & 15; return 8 * (i >> 2) + 4 * n + (i & 3); }

struct Unit { int pm, pn; };
struct Gemm { const bf16_t* A; const bf16_t* Bt; int M, N, K; };

struct StaticOrder {
    int nM, nN, nwg, G, c;
    __host__ __device__ void init(int M, int N, int G_, int c_) { nM = M / BM; nN = N / BM; nwg = nM * nN; G = G_; c = c_; }
    __host__ __device__ bool next(int i, Unit& u) const {
        const long L = (long)i * G + c; if (L >= nwg) return false;
        int wgid = (int)L; { const int q = nwg / NXCD, r = nwg % NXCD, xcd = wgid % NXCD, off = wgid / NXCD; wgid = (xcd < r ? xcd * (q + 1) : r * (q + 1) + (xcd - r) * q) + off; }
        const int nig = WGM * nN, gid = wgid / nig, fm = gid * WGM, gsz = (nM - fm) < WGM ? (nM - fm) : WGM;
        u.pm = fm + ((wgid % nig) % gsz); u.pn = (wgid % nig) / gsz; return true;
    }
    __device__ __forceinline__ void a_ready(const Unit&) const {}
    __device__ __forceinline__ void done(const Unit&) const {}
};
__device__ __forceinline__ unsigned cvt_pk_bf16(float lo, float hi) { unsigned r; asm volatile("v_cvt_pk_bf16_f32 %0, %1, %2" : "=v"(r) : "v"(lo), "v"(hi)); return r; }
template <class Epi, class Sched, bool ALIGN_EPI = false, bool SP2 = false>
__device__ __forceinline__ void gemm_phase(PG8_LAS unsigned char* lds, const Gemm g, const Sched& S, const Epi& E) {
    int tid_ = threadIdx.x; asm volatile("" : "+v"(tid_));
    const int tid = tid_, wid = __builtin_amdgcn_readfirstlane(tid >> 6), lane = tid & 63, wr = wid >> 2, wc = wid & 3, fr = lane & 15, fq = lane >> 4;
    const int K = g.K, nt = K / BK;
    unsigned voffA, voffB;
    { int R, C; stage_rc(tid * 16, R, C); const int Rb = Epi::PERM ? ((R & ~31) + perm32(R & 31)) : R;
      voffA = (unsigned)(R * K + C) * 2u; voffB = (unsigned)(Rb * K + C) * 2u; }
    const size_t r64 = (size_t)64 * K * 2;
    const size_t kstep = (size_t)(BK * 2);
    const size_t hstep = (size_t)HALF * K * 2;
    const size_t tstep = 2 * hstep;
    const unsigned ldsw = (unsigned)wid * 1024u;
    const int aoff = lds_byte(wr * 64 + fr, fq * 8), boff = lds_byte(wc * 32 + fr, fq * 8);
#define PG8_SA(b, h) (((b) * 2 + (h)) * HTB)
#define PG8_SB(b, h) ((4 + (b) * 2 + (h)) * HTB)
#define PG8_STAGE(bufoff, gbase, voff) do { _Pragma("unroll") for (int _i = 0; _i < 2; ++_i) \
        __builtin_amdgcn_global_load_lds((const unsigned*)((const char*)(gbase) + (size_t)_i * r64 + (voff)), (PG8_LAS unsigned*)(lds + (bufoff) + ldsw + _i * 8192), 16, 0, 0); } while (0)
#define PG8_LDA(dst, b, h) do { _Pragma("unroll") for (int m = 0; m < 4; ++m) _Pragma("unroll") for (int k = 0; k < 2; ++k) dst[m][k] = *(const PG8_LAS bf16x8*)(lds + PG8_SA(b, h) + aoff + m * 2048 + k * 1024); } while (0)
#define PG8_LDB(dst, b, h) do { _Pragma("unroll") for (int n = 0; n < 2; ++n) _Pragma("unroll") for (int k = 0; k < 2; ++k) dst[n][k] = *(const PG8_LAS bf16x8*)(lds + PG8_SB(b, h) + boff + n * 2048 + k * 1024); } while (0)
#define PG8_MMA(ai, bj, At, Bt) do { __builtin_amdgcn_s_setprio(1); _Pragma("unroll") for (int m = 0; m < 4; ++m) _Pragma("unroll") for (int n = 0; n < 2; ++n) _Pragma("unroll") for (int k = 0; k < 2; ++k) \
        acc[ai][bj][m][n] = __builtin_amdgcn_mfma_f32_16x16x32_bf16(Bt[n][k], At[m][k], acc[ai][bj][m][n], 0, 0, 0); __builtin_amdgcn_s_setprio(0); } while (0)
#define PG8_WAIT_V(n) asm volatile("s_waitcnt vmcnt(" #n ")" ::: "memory")
#define PG8_WAIT_L(n) asm volatile("s_waitcnt lgkmcnt(" #n ")" ::: "memory")
#define PG8_BAR __builtin_amdgcn_s_barrier()
#define PG8_SCHED __builtin_amdgcn_sched_barrier(0)
    Unit cur, nxt; int ui = 0;
    if (!S.next(0, cur)) return;
    f32x4 acc[2][2][4][2];
#pragma unroll
    for (int a = 0; a < 2; ++a)
#pragma unroll
        for (int b = 0; b < 2; ++b)
#pragma unroll
            for (int m = 0; m < 4; ++m)
#pragma unroll
                for (int n = 0; n < 2; ++n) acc[a][b][m][n] = (f32x4){0.f, 0.f, 0.f, 0.f};
    bf16x8 At[4][2], B0[2][2], B1[2][2];
    const char* cA = (const char*)g.A + (size_t)cur.pm * tstep; const char* cB = (const char*)g.Bt + (size_t)cur.pn * tstep;
    S.a_ready(cur);
    if constexpr (SP2) {
        PG8_STAGE(PG8_SB(0, 0), cB, voffB); PG8_STAGE(PG8_SB(0, 1), cB + hstep, voffB); PG8_STAGE(PG8_SA(0, 0), cA, voffA); PG8_STAGE(PG8_SA(0, 1), cA + hstep, voffA);
        if (wr == 1) PG8_BAR;
        PG8_WAIT_V(2); PG8_BAR;
        PG8_STAGE(PG8_SB(1, 0), cB + kstep, voffB); PG8_STAGE(PG8_SA(1, 0), cA + kstep, voffA); PG8_STAGE(PG8_SB(1, 1), cB + hstep + kstep, voffB);
        PG8_WAIT_V(6); PG8_BAR;
    } else {
        PG8_STAGE(PG8_SB(0, 0), cB, voffB); PG8_STAGE(PG8_SA(0, 0), cA, voffA); PG8_STAGE(PG8_SB(0, 1), cB + hstep, voffB); PG8_STAGE(PG8_SA(0, 1), cA + hstep, voffA);
        if (wr == 1) PG8_BAR;
        PG8_WAIT_V(4); PG8_BAR;
        PG8_STAGE(PG8_SB(1, 0), cB + kstep, voffB); PG8_STAGE(PG8_SA(1, 0), cA + kstep, voffA); PG8_STAGE(PG8_SB(1, 1), cB + hstep + kstep, voffB);
        PG8_WAIT_V(6); PG8_BAR;
    }
    for (;;) {
        const bool has_next = S.next(ui + 1, nxt);
        const char* nA = has_next ? (const char*)g.A + (size_t)nxt.pm * tstep : cA; const char* nB = has_next ? (const char*)g.Bt + (size_t)nxt.pn * tstep : cB;
        for (int t = 0; t < nt; t += 2) {
            const bool last = (t == nt - 2);
            const char* a1 = cA + (size_t)(t + 1) * kstep;
            const char* a2 = last ? nA : cA + (size_t)(t + 2) * kstep; const char* b2 = last ? nB : cB + (size_t)(t + 2) * kstep;
            const char* a3 = a2 + kstep; const char* b3 = b2 + kstep;
            if (last && has_next) S.a_ready(nxt);
            if constexpr (SP2) {
            PG8_LDB(B0, 0, 0); PG8_LDB(B1, 0, 1); PG8_SCHED; PG8_LDA(At, 0, 0); PG8_STAGE(PG8_SA(1, 1), a1 + hstep, voffA);
            PG8_WAIT_V(8); PG8_WAIT_L(0); PG8_BAR; PG8_MMA(0, 0, At, B0); PG8_MMA(0, 1, At, B1); PG8_BAR; PG8_SCHED;
            PG8_LDA(At, 0, 1); PG8_STAGE(PG8_SB(0, 0), b2, voffB); PG8_STAGE(PG8_SB(0, 1), b2 + hstep, voffB); PG8_STAGE(PG8_SA(0, 0), a2, voffA);
            PG8_WAIT_V(8); PG8_WAIT_L(0); PG8_BAR; PG8_MMA(1, 0, At, B0); PG8_MMA(1, 1, At, B1); PG8_BAR; PG8_SCHED;
            PG8_LDB(B0, 1, 0); PG8_LDB(B1, 1, 1); PG8_SCHED; PG8_LDA(At, 1, 0); PG8_STAGE(PG8_SA(0, 1), a2 + hstep, voffA);
            PG8_WAIT_V(8); PG8_WAIT_L(0); PG8_BAR; PG8_MMA(0, 0, At, B0); PG8_MMA(0, 1, At, B1); PG8_BAR; PG8_SCHED;
            PG8_LDA(At, 1, 1); PG8_STAGE(PG8_SB(1, 0), b3, voffB); PG8_STAGE(PG8_SB(1, 1), b3 + hstep, voffB); PG8_STAGE(PG8_SA(1, 0), a3, voffA);
            PG8_WAIT_V(8); PG8_WAIT_L(0); PG8_BAR; PG8_MMA(1, 0, At, B0); PG8_MMA(1, 1, At, B1); PG8_BAR; PG8_SCHED;
            } else {
            PG8_LDB(B0, 0, 0); PG8_SCHED; PG8_LDA(At, 0, 0); PG8_STAGE(PG8_SA(1, 1), a1 + hstep, voffA);
            PG8_WAIT_L(8); PG8_BAR; PG8_WAIT_L(0); PG8_MMA(0, 0, At, B0); PG8_BAR; PG8_SCHED;
            PG8_LDB(B1, 0, 1); PG8_STAGE(PG8_SB(0, 0), b2, voffB);
            PG8_BAR; PG8_WAIT_L(0); PG8_MMA(0, 1, At, B1); PG8_BAR;
            PG8_LDA(At, 0, 1); PG8_STAGE(PG8_SA(0, 0), a2, voffA);
            PG8_BAR; PG8_WAIT_L(0); PG8_MMA(1, 0, At, B0); PG8_BAR; PG8_SCHED;
            PG8_STAGE(PG8_SB(0, 1), b2 + hstep, voffB);
            PG8_WAIT_V(6); PG8_BAR; PG8_MMA(1, 1, At, B1); PG8_BAR;
            PG8_LDB(B0, 1, 0); PG8_SCHED; PG8_LDA(At, 1, 0); PG8_STAGE(PG8_SA(0, 1), a2 + hstep, voffA);
            PG8_WAIT_L(8); PG8_BAR; PG8_WAIT_L(0); PG8_MMA(0, 0, At, B0); PG8_BAR; PG8_SCHED;
            PG8_LDB(B1, 1, 1); PG8_STAGE(PG8_SB(1, 0), b3, voffB);
            PG8_BAR; PG8_WAIT_L(0); PG8_MMA(0, 1, At, B1); PG8_BAR;
            PG8_LDA(At, 1, 1); PG8_STAGE(PG8_SA(1, 0), a3, voffA);
            PG8_BAR; PG8_WAIT_L(0); PG8_MMA(1, 0, At, B0); PG8_BAR; PG8_SCHED;
            PG8_STAGE(PG8_SB(1, 1), b3 + hstep, voffB);
            PG8_WAIT_V(6); PG8_BAR; PG8_MMA(1, 1, At, B1); PG8_BAR;
            }
        }
        if constexpr (ALIGN_EPI) { if (wr == 0) PG8_BAR; }
        if constexpr (!Epi::AFTER_DRAIN) { E(acc, cur, wr, wc, fr, fq); S.done(cur); }
        if (!has_next) break;
#pragma unroll
        for (int a = 0; a < 2; ++a)
#pragma unroll
            for (int b = 0; b < 2; ++b)
#pragma unroll
                for (int m = 0; m < 4; ++m)
#pragma unroll
                    for (int n = 0; n < 2; ++n) acc[a][b][m][n] = (f32x4){0.f, 0.f, 0.f, 0.f};
        cur = nxt; cA = nA; cB = nB; ++ui;
        if constexpr (ALIGN_EPI) { if (wr == 1) PG8_BAR; }
    }
    PG8_WAIT_V(0);
    if constexpr (!ALIGN_EPI) { if (wr == 0) PG8_BAR; }
    PG8_BAR;
    if constexpr (Epi::AFTER_DRAIN) { E.fused(acc, cur, wr, wc, fr, fq, lds, wid, lane); S.done(cur); }
#undef PG8_SA
#undef PG8_SB
#undef PG8_STAGE
#undef PG8_LDA
#undef PG8_LDB
#undef PG8_MMA
#undef PG8_WAIT_V
#undef PG8_WAIT_L
#undef PG8_BAR
#undef PG8_SCHED
}
}

#define GAS __attribute__((address_space(1)))
#define LAS __attribute__((address_space(3)))
typedef unsigned short bf16;
typedef unsigned v4u __attribute__((ext_vector_type(4)));
typedef unsigned v2u __attribute__((ext_vector_type(2)));
typedef float f32x4 __attribute__((ext_vector_type(4)));
typedef float f32x16 __attribute__((ext_vector_type(16)));
typedef short bf16x8 __attribute__((ext_vector_type(8)));
typedef __bf16 bf16x2_t __attribute__((ext_vector_type(2)));
typedef float f32x2_t __attribute__((ext_vector_type(2)));
#define LDS_WAIT() asm volatile("s_waitcnt lgkmcnt(0)" ::: "memory")
#define MFMA32(a, b, c) __builtin_amdgcn_mfma_f32_32x32x16_bf16((a), (b), (c), 0, 0, 0)

constexpr int M = 32768, D = 1024, S = 2048, NBATCH = 16, FF = 2816, DIN = 9094, NQKV = 5120;
constexpr float LOG2E = 1.4426950408889634f, LN2 = 0.6931471805599453f;
constexpr float QSCALE = 0.125f * LOG2E;
constexpr float RMS_EPS = 1e-6f;
constexpr size_t MiB = 1u << 20;
constexpr size_t WS_CTL = 0, WS_LOGF = 1 * MiB, WS_W = 2 * MiB, W_LAYER = 56 * MiB, WS_HN = 114 * MiB, WS_BIG = 178 * MiB, WS_RSP = 507 * MiB, WS_END = 509 * MiB;
constexpr size_t W_1T = 0, W_2T = 11 * MiB, W_INT = 16 * MiB + MiB / 2, W_GT = 26 * MiB + MiB / 2, W_BRT = 34 * MiB + MiB / 2, W_OT = 37 * MiB + MiB / 2,
                 W_3T = 39 * MiB + MiB / 2, W_4T = 50 * MiB + MiB / 2;
constexpr size_t WB_A = 0, WB_B = 1 * MiB, WB_C = 1 * MiB + 3 * MiB / 4, WB_D = 2 * MiB + MiB / 2;
constexpr size_t B_QA = 0, B_QB = 32 * MiB, B_QC = 56 * MiB, B_OD = 80 * MiB, B_KA = 96 * MiB, B_VA = 128 * MiB, B_KB = 160 * MiB, B_VB = 184 * MiB,
                 B_KC = 208 * MiB, B_VC = 232 * MiB, B_QD = 256 * MiB, B_KD = 280 * MiB, B_VD = 304 * MiB;
constexpr size_t B_P = 96 * MiB, B_TMP = 160 * MiB, B_MRG = 224 * MiB;
constexpr int LDS_BYTES = 156672, LDS_BST = 155648 + 64;
constexpr int NTHREADS = 512;

struct Params;
typedef const __attribute__((address_space(4))) Params* PPtr;
struct Params {
    const float* in[22];
    float* out;
    unsigned char* ws;
    float lam_init[2];
    float one_minus_lam_init[2];
};

__device__ __forceinline__ int opaque_tid() { int t = threadIdx.x; asm volatile("" : "+v"(t)); return t; }
__device__ __forceinline__ unsigned f2bf(float f) { unsigned u = __builtin_bit_cast(unsigned, f); return (u + 0x7fffu + ((u >> 16) & 1u)) >> 16; }
__device__ __forceinline__ unsigned pk2(float lo, float hi) { f32x2_t v = {lo, hi}; bf16x2_t b = __builtin_convertvector(v, bf16x2_t); return __builtin_bit_cast(unsigned, b); }
__device__ __forceinline__ float bflo(unsigned w) { return __builtin_bit_cast(float, w << 16); }
__device__ __forceinline__ float bfhi(unsigned w) { return __builtin_bit_cast(float, w & 0xffff0000u); }
__device__ __forceinline__ float fexp2(float x) { return __builtin_amdgcn_exp2f(x); }
__device__ __forceinline__ float flog2(float x) { return __builtin_amdgcn_logf(x); }
__device__ __forceinline__ float sigmoidf_(float x) { return __builtin_amdgcn_rcpf(1.0f + fexp2(-x * LOG2E)); }
__device__ __forceinline__ float row_rs(const float* rsp, int row) {
    const f32x4* q = (const f32x4*)(rsp + (size_t)row * 16);
    const f32x4 a = q[0], b = q[1], c = q[2], d = q[3];
    const float s = ((a[0] + a[1]) + (a[2] + a[3])) + ((b[0] + b[1]) + (b[2] + b[3])) + ((c[0] + c[1]) + (c[2] + c[3])) + ((d[0] + d[1]) + (d[2] + d[3]));
    return rsqrtf(s * (1.0f / 1024.0f) + 1e-6f);
}
__device__ __forceinline__ float wave_sum(float v) {
#pragma unroll
    for (int o = 1; o < 64; o <<= 1) v += __shfl_xor(v, o);
    return v;
}

typedef const pg8::f32x4 (&AccRef)[2][2][4][2];

struct EpiSwiglu {
    static constexpr bool PERM = true, AFTER_DRAIN = false;
    bf16* U; const LAS float* rst;
    __device__ __forceinline__ void operator()(AccRef acc, const pg8::Unit& u, int wr, int wc, int fr, int fq) const {
        const int row0 = u.pm * 256 + wr * 64 + fr, col0 = u.pn * 128 + wc * 32 + 8 * fq;
#pragma unroll
        for (int ai = 0; ai < 2; ++ai)
#pragma unroll
            for (int m = 0; m < 4; ++m) {
                const int row = row0 + ai * 128 + m * 16;
                const float rs = rst[row & 255];
                float v[8];
#pragma unroll
                for (int n = 0; n < 2; ++n)
#pragma unroll
                    for (int j = 0; j < 4; ++j) { const float g = acc[ai][0][m][n][j] * rs, up = acc[ai][1][m][n][j] * rs; v[4 * n + j] = g * sigmoidf_(g) * up; }
                v4u w; w.x = pk2(v[0], v[1]); w.y = pk2(v[2], v[3]); w.z = pk2(v[4], v[5]); w.w = pk2(v[6], v[7]);
                *(v4u*)(U + (size_t)row * FF + col0) = w;
            }
    }
};

struct EpiResid {
    static constexpr bool PERM = true, AFTER_DRAIN = false;
    bf16* xb; float* outf; float scale; float* rss;
    __device__ __forceinline__ void operator()(AccRef acc, const pg8::Unit& u, int wr, int wc, int fr, int fq) const {
        const int row0 = u.pm * 256 + wr * 64 + fr, col0 = u.pn * 256 + wc * 32 + 8 * fq;
#pragma unroll
        for (int ai = 0; ai < 2; ++ai) {
            v4u xw[4][2];
#pragma unroll
            for (int m = 0; m < 4; ++m)
#pragma unroll
                for (int bj = 0; bj < 2; ++bj) xw[m][bj] = *(const v4u*)(xb + (size_t)(row0 + ai * 128 + m * 16) * D + col0 + bj * 128);
#pragma unroll
            for (int m = 0; m < 4; ++m) {
                const int row = row0 + ai * 128 + m * 16;
                float ss = 0.f;
#pragma unroll
                for (int bj = 0; bj < 2; ++bj) {
                    const size_t p = (size_t)row * D + col0 + bj * 128;
                    const v4u w0 = xw[m][bj];
                    f32x4 a = {bflo(w0.x), bfhi(w0.x), bflo(w0.y), bfhi(w0.y)}, b = {bflo(w0.z), bfhi(w0.z), bflo(w0.w), bfhi(w0.w)};
                    a = a + acc[ai][bj][m][0] * scale; b = b + acc[ai][bj][m][1] * scale;
                    if (outf) { *(f32x4*)(outf + p) = a; *(f32x4*)(outf + p + 4) = b; }
                    else {
                        ss += (a[0] * a[0] + a[1] * a[1]) + (a[2] * a[2] + a[3] * a[3]) + (b[0] * b[0] + b[1] * b[1]) + (b[2] * b[2] + b[3] * b[3]);
                        v4u w; w.x = pk2(a[0], a[1]); w.y = pk2(a[2], a[3]); w.z = pk2(b[0], b[1]); w.w = pk2(b[2], b[3]);
                        *(v4u*)(xb + p) = w;
                    }
                }
                if (!outf) {
                    ss += __shfl_xor(ss, 16); ss += __shfl_xor(ss, 32);
                    if (fq == 0) rss[(size_t)row * 16 + u.pn * 4 + wc] = ss;
                }
            }
        }
    }
};

struct EpiQKV {
    static constexpr bool PERM = true, AFTER_DRAIN = false;
    unsigned char* big; const float *aq, *ak, *cq, *ck, *dq, *dk, *fb; float* logf; const LAS float* rst;
    __device__ __forceinline__ void operator()(AccRef acc, const pg8::Unit& u, int wr, int wc, int fr, int fq) const {
        const int G = u.pn * 4 + wc;
        if (G >= 79) return;
        const int row0 = u.pm * 256 + wr * 64 + fr;
        if (G == 78) {
            if (fq == 0) {
#pragma unroll
                for (int ai = 0; ai < 2; ++ai)
#pragma unroll
                    for (int m = 0; m < 4; ++m) {
                        const int row = row0 + ai * 128 + m * 16;
                        const float rsr = rst[row & 255];
#pragma unroll
                        for (int e = 0; e < 6; ++e) {
                            const float x = acc[ai][0][m][e >> 2][e & 3] * rsr + fb[e];
                            const float ls = fminf(x, 0.f) - LN2 * flog2(1.0f + fexp2(-fabsf(x) * LOG2E));
                            logf[(size_t)row * 8 + e] = ls;
                        }
                    }
            }
            return;
        }
        size_t off; int pitch, lg; const float* gain = nullptr; float sc = 1.f;
        if (G < 8)       { off = B_QA; pitch = 512; lg = G;      gain = aq; sc = QSCALE; }
        else if (G < 16) { off = B_KA; pitch = 512; lg = G - 8;  gain = ak; }
        else if (G < 24) { off = B_VA; pitch = 512; lg = G - 16; }
        else if (G < 30) { off = B_QB; pitch = 384; lg = G - 24; sc = QSCALE; }
        else if (G < 36) { off = B_KB; pitch = 384; lg = G - 30; }
        else if (G < 42) { off = B_VB; pitch = 384; lg = G - 36; }
        else if (G < 48) { off = B_QC; pitch = 384; lg = G - 42; gain = cq; sc = QSCALE; }
        else if (G < 54) { off = B_KC; pitch = 384; lg = G - 48; gain = ck; }
        else if (G < 60) { off = B_VC; pitch = 384; lg = G - 54; }
        else if (G < 66) { off = B_QD; pitch = 384; lg = G - 60; gain = dq; sc = QSCALE; }
        else if (G < 72) { off = B_KD; pitch = 384; lg = G - 66; gain = dk; }
        else             { off = B_VD; pitch = 384; lg = G - 72; }
        bf16* dst = (bf16*)(big + off) + lg * 64 + 8 * fq;
        f32x4 gv[2][2];
#pragma unroll
        for (int bj = 0; bj < 2; ++bj)
#pragma unroll
            for (int n = 0; n < 2; ++n) {
                f32x4 g4 = {1.f, 1.f, 1.f, 1.f};
                if (gain) g4 = *(const f32x4*)(gain + 32 * bj + 8 * fq + 4 * n);
                gv[bj][n] = g4 * sc;
            }
#pragma unroll
        for (int ai = 0; ai < 2; ++ai)
#pragma unroll
            for (int m = 0; m < 4; ++m) {
                const int row = row0 + ai * 128 + m * 16;
                const float rsr = rst[row & 255];
                f32x4 xv[2][2];
#pragma unroll
                for (int bj = 0; bj < 2; ++bj)
#pragma unroll
                    for (int n = 0; n < 2; ++n) xv[bj][n] = acc[ai][bj][m][n] * rsr;
                float rs = 1.f;
                if (gain) {
                    float ss = 0.f;
#pragma unroll
                    for (int bj = 0; bj < 2; ++bj)
#pragma unroll
                        for (int n = 0; n < 2; ++n) { const f32x4 x = xv[bj][n]; ss += (x[0] * x[0] + x[1] * x[1]) + (x[2] * x[2] + x[3] * x[3]); }
                    ss += __shfl_xor(ss, 16); ss += __shfl_xor(ss, 32);
                    rs = rsqrtf(ss * (1.0f / 64.0f) + RMS_EPS);
                }
#pragma unroll
                for (int bj = 0; bj < 2; ++bj) {
                    const f32x4 v0 = xv[bj][0] * rs * gv[bj][0], v1 = xv[bj][1] * rs * gv[bj][1];
                    v4u w; w.x = pk2(v0[0], v0[1]); w.y = pk2(v0[2], v0[3]); w.z = pk2(v1[0], v1[1]); w.w = pk2(v1[2], v1[3]);
                    *(v4u*)(dst + (size_t)row * pitch + 32 * bj) = w;
                }
            }
    }
};

struct EpiPStore {
    static constexpr bool PERM = true, AFTER_DRAIN = false;
    v4u* P;
    __device__ __forceinline__ void operator()(AccRef acc, const pg8::Unit& u, int wr, int wc, int fr, int fq) const {
        v4u* base = P + (size_t)(u.pm * 4 + u.pn) * 16 * NTHREADS + opaque_tid();
#pragma unroll
        for (int ai = 0; ai < 2; ++ai)
#pragma unroll
            for (int bj = 0; bj < 2; ++bj)
#pragma unroll
                for (int m = 0; m < 4; ++m) {
                    const f32x4 v0 = acc[ai][bj][m][0], v1 = acc[ai][bj][m][1];
                    v4u w; w.x = pk2(v0[0], v0[1]); w.y = pk2(v0[2], v0[3]); w.z = pk2(v1[0], v1[1]); w.w = pk2(v1[2], v1[3]);
                    base[(size_t)((ai * 2 + bj) * 4 + m) * NTHREADS] = w;
                    }
    }
};

struct EpiGate {
    static constexpr bool PERM = true, AFTER_DRAIN = false;
    const float* gb; const v4u* P; v4u* TMP; bf16* MRG; int first, last; const LAS float* rst;
    __device__ __forceinline__ void operator()(AccRef acc, const pg8::Unit& u, int wr, int wc, int fr, int fq) const {
        const size_t ub = (size_t)(u.pm * 4 + u.pn) * 16 * NTHREADS + opaque_tid();
        const int row0 = u.pm * 256 + wr * 64 + fr, col0 = u.pn * 256 + wc * 32 + 8 * fq;
#pragma unroll
        for (int bj = 0; bj < 2; ++bj) {
            const f32x4 bv0 = *(const f32x4*)(gb + col0 + bj * 128), bv1 = *(const f32x4*)(gb + col0 + bj * 128 + 4);
#pragma unroll
            for (int ai = 0; ai < 2; ++ai) {
                v4u pw4[4], tw4[4];
#pragma unroll
                for (int m = 0; m < 4; ++m) {
                    const size_t ci = ub + (size_t)((ai * 2 + bj) * 4 + m) * NTHREADS;
                    pw4[m] = P[ci];
                    if (!first) tw4[m] = TMP[ci]; else tw4[m] = (v4u){0u, 0u, 0u, 0u};
                }
#pragma unroll
                for (int m = 0; m < 4; ++m) {
                    const size_t ci = ub + (size_t)((ai * 2 + bj) * 4 + m) * NTHREADS;
                    const v4u pw = pw4[m], tw = tw4[m];
                    const float rs = rst[(row0 + ai * 128 + m * 16) & 255];
                    float v[8];
                    v[0] = sigmoidf_(acc[ai][bj][m][0][0] * rs + bv0[0]) * bflo(pw.x); v[1] = sigmoidf_(acc[ai][bj][m][0][1] * rs + bv0[1]) * bfhi(pw.x);
                    v[2] = sigmoidf_(acc[ai][bj][m][0][2] * rs + bv0[2]) * bflo(pw.y); v[3] = sigmoidf_(acc[ai][bj][m][0][3] * rs + bv0[3]) * bfhi(pw.y);
                    v[4] = sigmoidf_(acc[ai][bj][m][1][0] * rs + bv1[0]) * bflo(pw.z); v[5] = sigmoidf_(acc[ai][bj][m][1][1] * rs + bv1[1]) * bfhi(pw.z);
                    v[6] = sigmoidf_(acc[ai][bj][m][1][2] * rs + bv1[2]) * bflo(pw.w); v[7] = sigmoidf_(acc[ai][bj][m][1][3] * rs + bv1[3]) * bfhi(pw.w);
                    v[0] += bflo(tw.x); v[1] += bfhi(tw.x); v[2] += bflo(tw.y); v[3] += bfhi(tw.y);
                    v[4] += bflo(tw.z); v[5] += bfhi(tw.z); v[6] += bflo(tw.w); v[7] += bfhi(tw.w);
                    v4u w; w.x = pk2(v[0], v[1]); w.y = pk2(v[2], v[3]); w.z = pk2(v[4], v[5]); w.w = pk2(v[6], v[7]);
                    if (!last) TMP[ci] = w;
                    else *(v4u*)(MRG + (size_t)(row0 + ai * 128 + m * 16) * D + col0 + bj * 128) = w;
                }
            }
        }
    }
};

__device__ __forceinline__ void tr_item(const float* src, int ldw, int k0, int n0, bf16* dst, int ldt, int drow0, int dk0, LAS float* scr, int lane, const float* gk = nullptr) {
#pragma unroll 8
    for (int i = 0; i < 32; ++i) { const int kk = 2 * i + (lane >> 5); scr[kk * 33 + (lane & 31)] = src[(size_t)(k0 + kk) * ldw + n0 + (lane & 31)]; }
    LDS_WAIT(); asm volatile("" ::: "memory");
    const int c = lane & 7;
    f32x4 g0 = {1.f, 1.f, 1.f, 1.f}, g1 = g0;
    if (gk) { g0 = *(const f32x4*)(gk + k0 + 8 * c); g1 = *(const f32x4*)(gk + k0 + 8 * c + 4); }
#pragma unroll
    for (int j = 0; j < 4; ++j) {
        const int n = (lane >> 3) + 8 * j; const LAS float* sp = scr + (8 * c) * 33 + n;
        v4u o; o.x = pk2(sp[0 * 33] * g0[0], sp[1 * 33] * g0[1]); o.y = pk2(sp[2 * 33] * g0[2], sp[3 * 33] * g0[3]);
        o.z = pk2(sp[4 * 33] * g1[0], sp[5 * 33] * g1[1]); o.w = pk2(sp[6 * 33] * g1[2], sp[7 * 33] * g1[3]);
        *(v4u*)(dst + (size_t)(drow0 + n) * ldt + dk0 + 8 * c) = o;
    }
    LDS_WAIT(); asm volatile("" ::: "memory");
}

constexpr int NJ1 = 2816, NJ2 = 1408, NJ3 = 2496, NJ4 = 2048, NJ5A = 256, NJ5B = 192, NJ5C = 192, NJ5D = 64, NJ6 = 512;
constexpr int NPL = NJ1 + NJ2 + NJ3 + NJ4 + NJ5A + NJ5B + NJ5C + NJ5D + NJ6 + NJ1 + NJ2;

__device__ __forceinline__ void ffn_in_item(const float* w, bf16* dst, int r, LAS float* scr, int lane, const float* gk) {
    const int kb = r / 176, nb = r % 176, c0 = 32 * nb;
    const int drow = (c0 < FF) ? 256 * (c0 / 128) + (c0 % 128) : 256 * ((c0 - FF) / 128) + 128 + ((c0 - FF) % 128);
    tr_item(w, 2 * FF, 64 * kb, c0, dst, D, drow, 64 * kb, scr, lane, gk);
}
__device__ __forceinline__ void plain_item(const float* w, int ldw, int krow0, bf16* dst, int ldt, int r, LAS float* scr, int lane) {
    const int kb = r >> 5, nb = r & 31;
    tr_item(w, ldw, krow0 + 64 * kb, 32 * nb, dst, ldt, 32 * nb, 64 * kb, scr, lane);
}

__device__ __forceinline__ void prologue_weights(const Params& p, LAS unsigned char* lds) {
    const int tid = threadIdx.x, lane = tid & 63, wave = tid >> 6;
    LAS float* scr = (LAS float*)(lds + wave * 16384);
    const int gw = blockIdx.x * 8 + wave, NGW = gridDim.x * 8;
    for (int it = gw; it < 2 * NPL; it += NGW) {
        const int l = it / NPL; int r = it % NPL;
        unsigned char* wb = p.ws + WS_W + (size_t)l * W_LAYER;
        if (r < NJ1) { ffn_in_item(p.in[3] + (size_t)l * D * 2 * FF, (bf16*)(wb + W_1T), r, scr, lane, p.in[2] + (size_t)l * D); continue; } r -= NJ1;
        if (r < NJ2) { plain_item(p.in[4] + (size_t)l * FF * D, D, 0, (bf16*)(wb + W_2T), FF, r, scr, lane); continue; } r -= NJ2;
        if (r < NJ3) {
            const int kb = r / 156, nb = r % 156, L0 = 32 * nb, n0 = (L0 < 3840) ? L0 : L0 + 6;
            const int drow = 256 * (L0 >> 8) + 128 * ((L0 & 63) >> 5) + 32 * ((L0 >> 6) & 3);
            tr_item(p.in[6] + (size_t)l * D * DIN, DIN, 64 * kb, n0, (bf16*)(wb + W_INT), D, drow, 64 * kb, scr, lane, p.in[5] + (size_t)l * D); continue; } r -= NJ3;
        if (r < NJ4) {
            const int kb = r >> 7, nb = r & 127;
            tr_item(p.in[6] + (size_t)l * D * DIN, DIN, 64 * kb, 4998 + 32 * nb, (bf16*)(wb + W_GT), D, 32 * nb, 64 * kb, scr, lane, p.in[5] + (size_t)l * D); continue; } r -= NJ4;
        const float* wbr = p.in[17] + (size_t)l * 1408 * D;
        if (r < NJ5A) { plain_item(wbr, D, 0, (bf16*)(wb + W_BRT + WB_A), 512, r, scr, lane); continue; } r -= NJ5A;
        if (r < NJ5B) { plain_item(wbr, D, 512, (bf16*)(wb + W_BRT + WB_B), 384, r, scr, lane); continue; } r -= NJ5B;
        if (r < NJ5C) { plain_item(wbr, D, 896, (bf16*)(wb + W_BRT + WB_C), 384, r, scr, lane); continue; } r -= NJ5C;
        if (r < NJ5D) { plain_item(wbr, D, 1280, (bf16*)(wb + W_BRT + WB_D), 256, r, scr, lane); continue; } r -= NJ5D;
        if (r < NJ6) { plain_item(p.in[18] + (size_t)l * D * D, D, 0, (bf16*)(wb + W_OT), D, r, scr, lane); continue; } r -= NJ6;
        if (r < NJ1) { ffn_in_item(p.in[20] + (size_t)l * D * 2 * FF, (bf16*)(wb + W_3T), r, scr, lane, p.in[19] + (size_t)l * D); continue; } r -= NJ1;
        plain_item(p.in[21] + (size_t)l * FF * D, D, 0, (bf16*)(wb + W_4T), FF, r, scr, lane);
    }
    const int gt = blockIdx.x * NTHREADS + tid, NGT = gridDim.x * NTHREADS;
    for (int i = gt; i < 2 * 131072; i += NGT) {
        const int l = i >> 17, q = i & 131071;
        unsigned char* wb = p.ws + WS_W + (size_t)l * W_LAYER;
        { const int idx = q >> 10, k = q & 1023, R = 4864 + (idx >> 6) * 128 + 64 + (idx & 63), e = R - 4928;
          float v = 0.f; if (e >= 0 && e < 6) v = p.in[6][(size_t)l * D * DIN + (size_t)k * DIN + 3840 + e] * p.in[5][(size_t)l * D + k];
          ((bf16*)(wb + W_INT))[(size_t)R * D + k] = (bf16)f2bf(v); }
        { const int row = q >> 7, col = 128 + (q & 127); ((bf16*)(wb + W_BRT + WB_D))[(size_t)row * 256 + col] = 0; }
    }
}

__device__ __forceinline__ void norm_phase(const float* x, bf16* hn, float* rss) {
    const int tid = opaque_tid(), lane = tid & 63, wave = tid >> 6;
    const int gw = blockIdx.x * 8 + wave, NGW = gridDim.x * 8;
    for (int row = gw; row < M; row += NGW) {
        const f32x4* xr = (const f32x4*)(x + (size_t)row * D) + lane;
        f32x4 v[4]; float sq = 0.f;
#pragma unroll
        for (int j = 0; j < 4; ++j) { v[j] = xr[64 * j]; sq += (v[j][0] * v[j][0] + v[j][1] * v[j][1]) + (v[j][2] * v[j][2] + v[j][3] * v[j][3]); }
        sq = wave_sum(sq);
        if (lane < 16) rss[(size_t)row * 16 + lane] = (lane == 0) ? sq : 0.f;
        v2u* o8 = (v2u*)(hn + (size_t)row * D) + lane;
#pragma unroll
        for (int j = 0; j < 4; ++j) { v2u w; w.x = pk2(v[j][0], v[j][1]); w.y = pk2(v[j][2], v[j][3]); o8[64 * j] = w; }
    }
}

constexpr int KPITCH = 72;
constexpr int AL_KS0 = 0, AL_KS1 = 9216, AL_VT0 = 36864, AL_VT1 = 54272, AL_LUT = 73728, AL_CB = 75776, AL_SCAN = 83968, AL_ITEM = 84032, AL_O0 = 86016;
constexpr float NEG_BIG = -1.0e4f;

template <int DV> struct TileRegs { v4u k; v4u v[DV / 64]; };

template <int DV> __device__ __forceinline__ void tile_load(TileRegs<DV>& R, const bf16* Kp, int kpitch, const bf16* Vp, int vpitch, int k0, int tid) {
    const int key = tid >> 3, c = tid & 7;
    R.k = *(const v4u*)(Kp + (unsigned)((k0 + key) * kpitch + 8 * c));
#pragma unroll
    for (int i = 0; i < DV / 64; ++i) R.v[i] = *(const v4u*)(Vp + (unsigned)((k0 + key) * vpitch + 64 * i + 8 * c));
}
template <int DV> __device__ __forceinline__ void tile_store(const TileRegs<DV>& R, LAS unsigned char* ks, LAS unsigned char* vt, int tid) {
    const int key = tid >> 3, c = tid & 7;
    *(LAS v4u*)(ks + (key * KPITCH + 8 * c) * 2) = R.k;
#pragma unroll
    for (int i = 0; i < DV / 64; ++i) *(LAS v4u*)(vt + (key * (DV + 8) + 64 * i + 8 * c) * 2) = R.v[i];
}
__device__ __forceinline__ bf16x8 pack8(const f32x16& s, int st) {
    v4u w;
    if (st == 0) { w.x = pk2(s[0], s[1]); w.y = pk2(s[2], s[3]); w.z = pk2(s[4], s[5]); w.w = pk2(s[6], s[7]); }
    else         { w.x = pk2(s[8], s[9]); w.y = pk2(s[10], s[11]); w.z = pk2(s[12], s[13]); w.w = pk2(s[14], s[15]); }
    return __builtin_bit_cast(bf16x8, w);
}
typedef short v4i16_t __attribute__((ext_vector_type(4)));
template <int DV> __device__ __forceinline__ bf16x8 vfrag(LAS unsigned char* vt, int dv0, int kbase, int lane) {
    const int i16 = lane & 15, q = i16 >> 2, pp_ = i16 & 3, blk = (lane >> 4) & 1;
    LAS unsigned char* p0 = vt + ((kbase + q) * (DV + 8) + dv0 + 16 * blk + 4 * pp_) * 2;
    const v4i16_t lo = __builtin_amdgcn_ds_read_tr16_b64_v4i16((LAS v4i16_t*)p0);
    const v4i16_t hi = __builtin_amdgcn_ds_read_tr16_b64_v4i16((LAS v4i16_t*)(p0 + 8 * (DV + 8) * 2));
    return __builtin_shufflevector(lo, hi, 0, 1, 2, 3, 4, 5, 6, 7);
}
__device__ __forceinline__ int rel_bucket(int n) {
    if (n < 16) return n;
    return 16 + (n >= 19) + (n >= 21) + (n >= 24) + (n >= 27) + (n >= 31) + (n >= 35) + (n >= 40) + (n >= 46) + (n >= 52) + (n >= 59) + (n >= 67) + (n >= 77) + (n >= 87) + (n >= 99) + (n >= 113);
}

template <int KIND>
__device__ __forceinline__ void softmax_tile(f32x16& s0, f32x16& s1, float& l, int t, int k0, int h, int qlo, const LAS float* lut, const LAS float* cb, int W, int dmask, float rowshift) {
    const float NINF = -__builtin_inff();
    if (KIND == 0) {
        if (k0 + 63 + 128 <= qlo) {
            const float c = lut[128];
#pragma unroll
            for (int i = 0; i < 16; ++i) { s0[i] += c; s1[i] += c; }
        } else {
#pragma unroll
            for (int i = 0; i < 16; ++i) {
                const int j0 = k0 + (i & 3) + 8 * (i >> 2) + 4 * h, n0 = t - j0, n1 = n0 - 32;
                const float b0 = lut[min(max(n0, 0), 128)], b1 = lut[min(max(n1, 0), 128)];
                s0[i] = (n0 >= 0) ? s0[i] + b0 : NINF; s1[i] = (n1 >= 0) ? s1[i] + b1 : NINF;
            }
        }
    } else if (KIND == 1) {
        const bool diag = (k0 + 63 > qlo);
#pragma unroll
        for (int c = 0; c < 4; ++c) {
            const f32x4 b0 = *(const LAS f32x4*)(cb + k0 + 8 * c + 4 * h), b1 = *(const LAS f32x4*)(cb + k0 + 32 + 8 * c + 4 * h);
#pragma unroll
            for (int jj = 0; jj < 4; ++jj) {
                const int i = 4 * c + jj; const int n0 = t - (k0 + 8 * c + 4 * h + jj), n1 = n0 - 32;
                float x0 = s0[i] + (b0[jj] + rowshift), x1 = s1[i] + (b1[jj] + rowshift);
                if (diag) { x0 = (n0 >= 0) ? x0 : NINF; x1 = (n1 >= 0) ? x1 : NINF; }
                s0[i] = x0; s1[i] = x1;
            }
        }
    } else {
#pragma unroll
        for (int i = 0; i < 16; ++i) {
            const int j0 = k0 + (i & 3) + 8 * (i >> 2) + 4 * h, n0 = t - j0, n1 = n0 - 32;
            const float b0 = lut[min(max(n0, 0), 128)], b1 = lut[min(max(n1, 0), 128)];
            const bool v0 = (n0 >= 0) && (n0 <= W) && ((n0 & dmask) == 0), v1 = (n1 >= 0) && (n1 <= W) && ((n1 & dmask) == 0);
            s0[i] = v0 ? s0[i] + b0 : NINF; s1[i] = v1 ? s1[i] + b1 : NINF;
        }
    }
    float ps = 0.f;
#pragma unroll
    for (int i = 0; i < 16; ++i) { s0[i] = fexp2(s0[i]); s1[i] = fexp2(s1[i]); ps += s0[i] + s1[i]; }
    l += ps;
}

__device__ __forceinline__ void stick_block(f32x16& s, float& Rr, int t, int kbase, int h, bool diag) {
    float u[16], gs[4], pg[4];
#pragma unroll
    for (int i = 0; i < 16; ++i) {
        const float z = s[i];
        const float sp = fmaxf(z, 0.f) + flog2(1.0f + fexp2(-fabsf(z)));
        const int j = kbase + (i & 3) + 8 * (i >> 2) + 4 * h;
        const bool valid = !diag || (j < t);
        u[i] = valid ? -sp : 0.f;
        s[i] = valid ? (z - sp) : -__builtin_inff();
    }
#pragma unroll
    for (int c = 0; c < 4; ++c) { gs[c] = (u[4 * c] + u[4 * c + 1]) + (u[4 * c + 2] + u[4 * c + 3]); pg[c] = __shfl_xor(gs[c], 32); }
    float run = Rr;
#pragma unroll
    for (int c = 3; c >= 0; --c) {
        float tl = run + ((h == 0) ? pg[c] : 0.f);
#pragma unroll
        for (int jj = 3; jj >= 0; --jj) { const int i = 4 * c + jj; const float a = fexp2(s[i] + tl); tl += u[i]; s[i] = a; }
        run += gs[c] + pg[c];
    }
    Rr = run;
}

template <int KIND  , int DV>
__device__ __forceinline__ void attn_pass(LAS unsigned char* L, const bf16* Qp, int qpitch, const bf16* Kp, int kpitch, const bf16* Vp, int vpitch,
                                          int q0w, int t_lo, int t_hi, f32x16 (&o)[DV / 32], const float bnd, float& l, float& Rr,
                                          const LAS float* lut, const LAS float* cb, int W, int dmask, const int tid, const bool wave_on = true) {
    const int lane = tid & 63, r = lane & 31, h = lane >> 5;
    const int t = q0w + r, qlo = q0w, qhi = wave_on ? q0w + 31 : -1;
    bf16x8 qf[4];
#pragma unroll
    for (int ks = 0; ks < 4; ++ks) qf[ks] = *(const bf16x8*)(Qp + (unsigned)((wave_on ? t : 0) * qpitch + 16 * ks + 8 * h));
    TileRegs<DV> TA, TB;
    __syncthreads();
    tile_load<DV>(TA, Kp, kpitch, Vp, vpitch, t_hi * 64, tid);
    tile_store<DV>(TA, L + AL_KS0, L + AL_VT0, tid);
    if (t_hi - 1 >= t_lo) tile_load<DV>(TA, Kp, kpitch, Vp, vpitch, (t_hi - 1) * 64, tid);
    float rowshift = 0.f;
    if (KIND == 1) rowshift = -cb[t] - bnd;
    int buf = 0;
#define ATTN_STEP(TCUR, TNXT)                                                                                                          \
    {                                                                                                                                   \
        __syncthreads();                                                                                                                \
        if (tt - 2 >= t_lo) tile_load<DV>(TNXT, Kp, kpitch, Vp, vpitch, (tt - 2) * 64, tid);                                            \
        const int k0 = tt * 64;                                                                                                         \
        bool active = (k0 <= qhi);                                                                                                      \
        if (KIND == 2) active = active && (k0 + 63 >= qlo - W);                                                                         \
        if (active) {                                                                                                                   \
            LAS unsigned char* ks = L + (buf ? AL_KS1 : AL_KS0);                                                                        \
            LAS unsigned char* vt = L + (buf ? AL_VT1 : AL_VT0);                                                                        \
            f32x16 s0, s1;                                                                                                              \
            _Pragma("unroll") for (int i = 0; i < 16; ++i) { s0[i] = 0.f; s1[i] = 0.f; }                                                \
            _Pragma("unroll") for (int kk = 0; kk < 4; ++kk) {                                                                          \
                const bf16x8 a0 = *(const LAS bf16x8*)(ks + (r * KPITCH + 16 * kk + 8 * h) * 2);                                        \
                const bf16x8 a1 = *(const LAS bf16x8*)(ks + ((32 + r) * KPITCH + 16 * kk + 8 * h) * 2);                                 \
                s0 = MFMA32(a0, qf[kk], s0); s1 = MFMA32(a1, qf[kk], s1);                                                               \
            }                                                                                                                           \
            if (KIND == 3) {                                                                                                            \
                const bool diag = (k0 + 63 >= qlo);                                                                                     \
                stick_block(s1, Rr, t, k0 + 32, h, diag);                                                                               \
                stick_block(s0, Rr, t, k0, h, diag);                                                                                    \
            } else {                                                                                                                    \
                softmax_tile<KIND>(s0, s1, l, t, k0, h, qlo, lut, cb, W, dmask, rowshift);                                              \
            }                                                                                                                           \
            _Pragma("unroll") for (int st = 0; st < 2; ++st) {                                                                          \
                const bf16x8 pb = pack8(s0, st);                                                                                        \
                _Pragma("unroll") for (int db = 0; db < DV / 32; ++db) o[db] = MFMA32(vfrag<DV>(vt, 32 * db, 16 * st + 4 * h, lane), pb, o[db]);      \
            }                                                                                                                           \
            _Pragma("unroll") for (int st = 0; st < 2; ++st) {                                                                          \
                const bf16x8 pb = pack8(s1, st);                                                                                        \
                _Pragma("unroll") for (int db = 0; db < DV / 32; ++db) o[db] = MFMA32(vfrag<DV>(vt, 32 * db, 32 + 16 * st + 4 * h, lane), pb, o[db]); \
            }                                                                                                                           \
        }                                                                                                                               \
        if (tt - 1 >= t_lo) tile_store<DV>(TCUR, L + (buf ? AL_KS0 : AL_KS1), L + (buf ? AL_VT0 : AL_VT1), tid);                        \
        buf ^= 1;                                                                                                                       \
    }
    for (int tt = t_hi; tt >= t_lo; tt -= 2) {
        ATTN_STEP(TA, TB)
        if (tt - 1 < t_lo) break;
        { const int tt_save = tt; (void)tt_save; }
        tt -= 1;
        ATTN_STEP(TB, TA)
        tt += 1;
    }
#undef ATTN_STEP
}

__device__ __forceinline__ void qk_tile(LAS unsigned char* ks, const bf16x8 (&qf)[4], int r, int h, f32x16& s0, f32x16& s1) {
    bf16x8 kf[8];
#pragma unroll
    for (int kk = 0; kk < 4; ++kk) {
        kf[2 * kk]     = *(const LAS bf16x8*)(ks + (r * KPITCH + 16 * kk + 8 * h) * 2);
        kf[2 * kk + 1] = *(const LAS bf16x8*)(ks + ((32 + r) * KPITCH + 16 * kk + 8 * h) * 2);
    }
#pragma unroll
    for (int i = 0; i < 16; ++i) { s0[i] = 0.f; s1[i] = 0.f; }
#pragma unroll
    for (int kk = 0; kk < 4; ++kk) { s0 = MFMA32(kf[2 * kk], qf[kk], s0); s1 = MFMA32(kf[2 * kk + 1], qf[kk], s1); }
}
__device__ __forceinline__ void pv_tile(LAS unsigned char* vt, const f32x16& s0, const f32x16& s1, int h, int lane, f32x16 (&o)[2]) {
#pragma unroll
    for (int st = 0; st < 2; ++st) {
        const bf16x8 pb = pack8(s0, st);
#pragma unroll
        for (int db = 0; db < 2; ++db) o[db] = MFMA32(vfrag<64>(vt, 32 * db, 16 * st + 4 * h, lane), pb, o[db]);
    }
#pragma unroll
    for (int st = 0; st < 2; ++st) {
        const bf16x8 pb = pack8(s1, st);
#pragma unroll
        for (int db = 0; db < 2; ++db) o[db] = MFMA32(vfrag<64>(vt, 32 * db, 32 + 16 * st + 4 * h, lane), pb, o[db]);
    }
}
template <int KIND  >
__device__ __forceinline__ void score_tile(f32x16& s0, f32x16& s1, float& l, float& Rr, int t, int k0, int h, int qlo, const LAS float* lut, const LAS float* cb, int W, int dmask, float rowshift) {
    if (KIND == 3) { const bool diag = (k0 + 63 >= qlo); stick_block(s1, Rr, t, k0 + 32, h, diag); stick_block(s0, Rr, t, k0, h, diag); }
    else softmax_tile<KIND>(s0, s1, l, t, k0, h, qlo, lut, cb, W, dmask, rowshift);
}

template <int KIND  >
__device__ __forceinline__ void attn_pass2(LAS unsigned char* L, const bf16* Qp, int qpitch, const bf16* Kp, int kpitch, const bf16* Vp, int vpitch,
                                           int q0w, int t_lo, int t_hi, f32x16 (&o)[2], const float bnd, float& l, float& Rr,
                                           const LAS float* lut, const LAS float* cb, int W, int dmask, const int tid, const bool wave_on = true) {
    const int lane = tid & 63, r = lane & 31, h = lane >> 5;
    const int t = q0w + r, qlo = q0w, qhi = wave_on ? q0w + 31 : -1;
    bf16x8 qf[4];
#pragma unroll
    for (int ks = 0; ks < 4; ++ks) qf[ks] = *(const bf16x8*)(Qp + (unsigned)((wave_on ? t : 0) * qpitch + 16 * ks + 8 * h));
    TileRegs<64> TA, TB;
    __syncthreads();
    tile_load<64>(TA, Kp, kpitch, Vp, vpitch, t_hi * 64, tid);
    if (t_hi - 1 >= t_lo) tile_load<64>(TB, Kp, kpitch, Vp, vpitch, (t_hi - 1) * 64, tid);
    tile_store<64>(TA, L + 0, L + 36864, tid);
    if (t_hi - 1 >= t_lo) tile_store<64>(TB, L + 9216, L + 36864 + 9216, tid);
    if (t_hi - 2 >= t_lo) tile_load<64>(TA, Kp, kpitch, Vp, vpitch, (t_hi - 2) * 64, tid);
    if (t_hi - 3 >= t_lo) tile_load<64>(TB, Kp, kpitch, Vp, vpitch, (t_hi - 3) * 64, tid);
    float rowshift = 0.f;
    if (KIND == 1) rowshift = -cb[t] - bnd;
    volatile LAS int* dflag = (volatile LAS int*)(L + AL_ITEM + 32);
    const int wv = tid >> 6;
    if (KIND == 3 && lane == 0) { dflag[wv] = 0; dflag[8 + wv] = 0; }
    bool wdone = false; int it = 0;
    int par = 0;
    for (int tt = t_hi; tt >= t_lo; tt -= 2, ++it) {
        __syncthreads();
        if (KIND == 3) {
            const int rb = ((it + 1) & 1) * 8;
            const int alld = dflag[rb] & dflag[rb + 1] & dflag[rb + 2] & dflag[rb + 3] & dflag[rb + 4] & dflag[rb + 5] & dflag[rb + 6] & dflag[rb + 7];
            if (alld) break;
        }
        const int k0a = tt * 64, k0b = k0a - 64;
        bool actA = (k0a <= qhi), actB = (tt - 1 >= t_lo) && (k0b <= qhi);
        if (KIND == 2) { actA = actA && (k0a + 63 >= qlo - W); actB = actB && (k0b + 63 >= qlo - W); }
        if (KIND == 3) { actA = actA && !wdone; actB = actB && !wdone; }
        if (KIND == 1) {
            actA = actA && (cb[k0a + 63] - cb[qlo] >= -152.0f); actB = actB && (k0b >= 0) && (cb[max(k0b, 0) + 63] - cb[qlo] >= -152.0f); }
        LAS unsigned char* ksA = L + par * 9216;       LAS unsigned char* vtA = L + 36864 + par * 9216;
        LAS unsigned char* ksB = L + (par + 1) * 9216; LAS unsigned char* vtB = L + 36864 + (par + 1) * 9216;
        if (actA && actB) {
            f32x16 a0, a1, b0, b1;
            qk_tile(ksA, qf, r, h, a0, a1);
            qk_tile(ksB, qf, r, h, b0, b1);
            score_tile<KIND>(a0, a1, l, Rr, t, k0a, h, qlo, lut, cb, W, dmask, rowshift);
            pv_tile(vtA, a0, a1, h, lane, o);
            score_tile<KIND>(b0, b1, l, Rr, t, k0b, h, qlo, lut, cb, W, dmask, rowshift);
            pv_tile(vtB, b0, b1, h, lane, o);
        } else if (actA) {
            f32x16 a0, a1;
            qk_tile(ksA, qf, r, h, a0, a1);
            score_tile<KIND>(a0, a1, l, Rr, t, k0a, h, qlo, lut, cb, W, dmask, rowshift);
            pv_tile(vtA, a0, a1, h, lane, o);
        } else if (actB) {
            f32x16 b0, b1;
            qk_tile(ksB, qf, r, h, b0, b1);
            score_tile<KIND>(b0, b1, l, Rr, t, k0b, h, qlo, lut, cb, W, dmask, rowshift);
            pv_tile(vtB, b0, b1, h, lane, o);
        }
        if (KIND == 3) {
            wdone = wdone || (wave_on ? (__all(Rr < -152.0f) != 0) : true);
            if (lane == 0) dflag[(it & 1) * 8 + wv] = wdone ? 1 : 0;
        }
        const int np = par ^ 2;
        if (tt - 2 >= t_lo) tile_store<64>(TA, L + np * 9216, L + 36864 + np * 9216, tid);
        if (tt - 3 >= t_lo) tile_store<64>(TB, L + (np + 1) * 9216, L + 36864 + (np + 1) * 9216, tid);
        if (tt - 4 >= t_lo) tile_load<64>(TA, Kp, kpitch, Vp, vpitch, (tt - 4) * 64, tid);
        if (tt - 5 >= t_lo) tile_load<64>(TB, Kp, kpitch, Vp, vpitch, (tt - 5) * 64, tid);
        par = np;
    }
}

template <int NB> __device__ __forceinline__ void zero_o(f32x16 (&o)[NB]) {
#pragma unroll
    for (int b = 0; b < NB; ++b)
#pragma unroll
        for (int i = 0; i < 16; ++i) o[b][i] = 0.f;
}
__device__ __forceinline__ void store_o64(const f32x16 (&o)[2], float inv, bf16* orow, int h) {
#pragma unroll
    for (int db = 0; db < 2; ++db)
#pragma unroll
        for (int c = 0; c < 4; ++c) {
            v2u w; w.x = pk2(o[db][4 * c] * inv, o[db][4 * c + 1] * inv); w.y = pk2(o[db][4 * c + 2] * inv, o[db][4 * c + 3] * inv);
            *(v2u*)(orow + 32 * db + 8 * c + 4 * h) = w;
        }
}

constexpr int N_ABC_ITEMS = 512 + 4 * 192, N_ATT_ITEMS = N_ABC_ITEMS + 1024;
constexpr size_t DP_O = 0, DP_L = (size_t)48 << 20;

__device__ __forceinline__ void attention_phase(PPtr p, int layer, LAS unsigned char* L, unsigned* counter, const bool do_store) {
    const int tid = opaque_tid(), lane = tid & 63, wave = tid >> 6, r = lane & 31, h = lane >> 5;
    unsigned char* big = p->ws + WS_BIG;
    LAS float* lut = (LAS float*)(L + AL_LUT);
    LAS float* cb = (LAS float*)(L + AL_CB);
    LAS float* scan = (LAS float*)(L + AL_SCAN);
    volatile LAS unsigned* itemw = (volatile LAS unsigned*)(L + AL_ITEM);
    const float* rel = p->in[1];
    for (;;) {
        __syncthreads();
        if (tid == 0) itemw[0] = atomicAdd(counter, 1u);
        __syncthreads();
        const int idx = (int)itemw[0];
        if (idx >= N_ATT_ITEMS) break;
        int tl_ = tid; asm volatile("" : "+v"(tl_));
        const int lane = tl_ & 63, r = lane & 31, h = lane >> 5;
        int qb, rr, dsel = 0;
        if (idx < 512) { qb = 7 - (idx >> 6); rr = idx & 63; }
        else if (idx < N_ABC_ITEMS) { const int j = idx - 512; qb = 3 - j / 192; rr = 64 + j % 192; }
        else { dsel = idx - N_ABC_ITEMS; qb = 0; rr = 256; }
#ifdef PROBE_ATT_TYPE
        if (!do_store) { const int ty = (rr < 64) ? 0 : (rr < 160 ? 1 : (rr < 256 ? 2 : 3)); if (ty != PROBE_ATT_TYPE) continue; }
#endif
        const int q0blk = qb * 256, q0w = q0blk + 32 * wave;
        const int t_hi = (q0blk + 255) >> 6;
        float dummyR = 0.f;
        if (rr < 64) {
            const int b = rr >> 2, hd = rr & 3;
            float bnd;
            {
                float mq = fabsf(p->in[9][layer * 64 + lane]), mk = fabsf(p->in[10][layer * 64 + lane]), mb = (lane < 32) ? fabsf(rel[lane * 10 + hd]) : 0.f;
#pragma unroll
                for (int o_ = 1; o_ < 64; o_ <<= 1) { mq = fmaxf(mq, __shfl_xor(mq, o_)); mk = fmaxf(mk, __shfl_xor(mk, o_)); mb = fmaxf(mb, __shfl_xor(mb, o_)); }
                bnd = 64.f * mq * mk * QSCALE * 1.02f + mb * LOG2E + 0.5f;
            }
            if (tid <= 128) lut[tid] = rel[rel_bucket(tid) * 10 + hd] * LOG2E - bnd;
            const float* lv = p->in[11] + (size_t)layer * 256;
            const float lam = expf(wave_sum(lv[lane] * lv[64 + lane])) - expf(wave_sum(lv[128 + lane] * lv[192 + lane])) + p->lam_init[layer];
            const size_t rowb = (size_t)b * S;
            bf16* QA = (bf16*)(big + B_QA) + rowb * 512 + hd * 128;
            const bf16* KA = (const bf16*)(big + B_KA) + rowb * 512 + hd * 128;
            const bf16* VA = (const bf16*)(big + B_VA) + rowb * 512 + hd * 128;
            LAS unsigned* o0p = (LAS unsigned*)(L + AL_O0) + tid;
            f32x16 o[4]; float l;
            zero_o<4>(o); l = 0.f;
            attn_pass<0, 128>(L, QA, 512, KA, 512, VA, 512, q0w, 0, t_hi, o, bnd, l, dummyR, lut, cb, 0, 0, tid);
            { const float inv = 1.0f / (l + __shfl_xor(l, 32));
#pragma unroll
              for (int db = 0; db < 4; ++db)
#pragma unroll
                  for (int i = 0; i < 8; ++i) o0p[(db * 8 + i) * NTHREADS] = pk2(o[db][2 * i] * inv, o[db][2 * i + 1] * inv); }
            zero_o<4>(o); l = 0.f;
            attn_pass<0, 128>(L, QA + 64, 512, KA + 64, 512, VA, 512, q0w, 0, t_hi, o, bnd, l, dummyR, lut, cb, 0, 0, tid);
            { const float inv = lam / (l + __shfl_xor(l, 32));
              float ss = 0.f;
#pragma unroll
              for (int db = 0; db < 4; ++db)
#pragma unroll
                  for (int i = 0; i < 8; ++i) {
                      const unsigned w0 = o0p[(db * 8 + i) * NTHREADS];
                      const float a = bflo(w0) - o[db][2 * i] * inv, c = bfhi(w0) - o[db][2 * i + 1] * inv;
                      o[db][2 * i] = a; o[db][2 * i + 1] = c; ss += a * a + c * c;
                  }
              ss += __shfl_xor(ss, 32);
              const float rs = rsqrtf(ss * (1.0f / 128.0f) + RMS_EPS) * p->one_minus_lam_init[layer];
              const float* sg = p->in[12] + (size_t)layer * 128;
              bf16* orow = QA + (size_t)(q0w + r) * 512;
              if (do_store)
#pragma unroll
              for (int db = 0; db < 4; ++db)
#pragma unroll
                  for (int c = 0; c < 4; ++c) {
                      const int dv = 32 * db + 8 * c + 4 * h;
                      const f32x4 g4 = *(const f32x4*)(sg + dv);
                      v2u w; w.x = pk2(o[db][4 * c] * rs * g4[0], o[db][4 * c + 1] * rs * g4[1]); w.y = pk2(o[db][4 * c + 2] * rs * g4[2], o[db][4 * c + 3] * rs * g4[3]);
                      *(v2u*)(orow + dv) = w;
                  }
            }
        } else if (rr < 160) {
            const int q = rr - 64, b = q / 6, hd = q % 6;
            const size_t rowb = (size_t)b * S;
            bf16* QB = (bf16*)(big + B_QB) + rowb * 384 + hd * 64;
            const bf16* KB = (const bf16*)(big + B_KB) + rowb * 384 + hd * 64;
            const bf16* VB = (const bf16*)(big + B_VB) + rowb * 384 + hd * 64;
#pragma unroll 1
            for (int sub = 0; sub < 2; ++sub) {
                const int q0b_s = (2 * qb + 1 - sub) * 256, q0w_s = q0b_s + 32 * wave, thi_s = (q0b_s + 255) >> 6;
                f32x16 o[2]; float l = 0.f, Rr = 0.f;
                zero_o<2>(o);
                attn_pass2<3>(L, QB, 384, KB, 384, VB, 384, q0w_s, 0, thi_s, o, 0.f, l, Rr, lut, cb, 0, 0, tid);
                if (do_store) store_o64(o, 1.0f, QB + (size_t)(q0w_s + r) * 384, h);
            }
        } else if (rr < 256) {
            const int q = rr - 160, b = q / 6, hd = q % 6;
            const size_t rowb = (size_t)b * S;
            {
                const int qend = (2 * qb + 2) * 256;
                const float* lf = (const float*)(p->ws + WS_LOGF) + rowb * 8 + hd;
                int tq = tid; asm volatile("" : "+v"(tq));
                float v[4];
#pragma unroll
                for (int i = 0; i < 4; ++i) { const int tok = 4 * tq + i; v[i] = (tok < qend) ? lf[(size_t)tok * 8] : 0.f; }
                v[1] += v[0]; v[2] += v[1]; v[3] += v[2];
                float incl = v[3];
#pragma unroll
                for (int off = 1; off < 64; off <<= 1) { const float y = __shfl_up(incl, off); if (lane >= off) incl += y; }
                if (lane == 63) scan[wave] = incl;
                __syncthreads();
                float pre = incl - v[3];
                for (int w2 = 0; w2 < wave; ++w2) pre += scan[w2];
#pragma unroll
                for (int i = 0; i < 4; ++i) cb[4 * tid + i] = -(pre + v[i]) * LOG2E;
            }
            bf16* QC = (bf16*)(big + B_QC) + rowb * 384 + hd * 64;
            const bf16* KC = (const bf16*)(big + B_KC) + rowb * 384 + hd * 64;
            const bf16* VC = (const bf16*)(big + B_VC) + rowb * 384 + hd * 64;
            float bnd;
            {   float mq = fabsf(p->in[13][layer * 64 + lane]), mk = fabsf(p->in[14][layer * 64 + lane]);
#pragma unroll
                for (int o_ = 1; o_ < 64; o_ <<= 1) { mq = fmaxf(mq, __shfl_xor(mq, o_)); mk = fmaxf(mk, __shfl_xor(mk, o_)); }
                bnd = 64.f * mq * mk * QSCALE * 1.02f + 0.5f; }
            __syncthreads();
#pragma unroll 1
            for (int sub = 0; sub < 2; ++sub) {
                const int q0b_s = (2 * qb + 1 - sub) * 256, q0w_s = q0b_s + 32 * wave, thi_s = (q0b_s + 255) >> 6;
                f32x16 o[2]; float l = 0.f;
                zero_o<2>(o);
                int tlc = 0;
                while (tlc < thi_s && (cb[64 * tlc + 63] - cb[q0b_s] < -152.0f)) ++tlc;
                attn_pass2<1>(L, QC, 384, KC, 384, VC, 384, q0w_s, tlc, thi_s, o, bnd, l, dummyR, lut, cb, 0, 0, tid);
                const float inv = 1.0f / (l + __shfl_xor(l, 32));
                if (do_store) store_o64(o, inv, QC + (size_t)(q0w_s + r) * 384, h);
            }
        } else {
            int g, dd, rho, q0v, bh;
            if (dsel < 256)      { g = 0; dd = 1;  bh = dsel & 31; rho = 0; q0v = (7 - (dsel >> 5)) * 256; }
            else if (dsel < 512) { const int j = dsel - 256; g = 1; dd = 4; bh = j & 31; rho = (j >> 5) & 3; q0v = (1 - (j >> 7)) * 256; }
            else                 { const int j = dsel - 512; g = 2; dd = 16; bh = j & 31; rho = j >> 5; q0v = 0; }
            const int b = bh >> 1, hs = bh & 1, Sv = S / dd;
            const size_t rowb = (size_t)b * S;
            float bnd;
            {   float mq = fabsf(p->in[15][layer * 64 + lane]), mk = fabsf(p->in[16][layer * 64 + lane]);
                float mb = (lane < 32) ? fmaxf(fmaxf(fabsf(rel[lane * 10 + 4 + hs]), fabsf(rel[lane * 10 + 6 + hs])), fabsf(rel[lane * 10 + 8 + hs])) : 0.f;
#pragma unroll
                for (int o_ = 1; o_ < 64; o_ <<= 1) { mq = fmaxf(mq, __shfl_xor(mq, o_)); mk = fmaxf(mk, __shfl_xor(mk, o_)); mb = fmaxf(mb, __shfl_xor(mb, o_)); }
                bnd = 64.f * mq * mk * QSCALE * 1.02f + mb * LOG2E + 0.5f; }
            if (tid <= 128) lut[tid] = rel[rel_bucket(min(dd * tid, 2047)) * 10 + 4 + 2 * g + hs] * LOG2E - bnd;
            const int col = (2 * g + hs) * 64;
            const bf16* QD = (const bf16*)(big + B_QD) + (rowb + rho) * 384 + col;
            const bf16* KD = (const bf16*)(big + B_KD) + (rowb + rho) * 384 + col;
            const bf16* VD = (const bf16*)(big + B_VD) + (rowb + rho) * 384 + col;
            const int q0wv = q0v + 32 * wave;
            const bool won = q0wv < Sv;
            const int thv = (min(q0v + 255, Sv - 1)) >> 6, tlv = max(0, q0v - 128) >> 6;
            f32x16 o[2]; float l = 0.f;
            zero_o<2>(o);
            attn_pass<2, 64>(L, QD, 384 * dd, KD, 384 * dd, VD, 384 * dd, q0wv, tlv, thv, o, bnd, l, dummyR, lut, cb, 128, 0, tid, won);
            const float lt = l + __shfl_xor(l, 32);
            if (won && do_store) {
                const size_t tok = rowb + rho + (size_t)dd * (q0wv + r);
                float* po = (float*)((unsigned char*)p->out + DP_O) + ((size_t)g * M + tok) * 128 + hs * 64;
#pragma unroll
                for (int db = 0; db < 2; ++db)
#pragma unroll
                    for (int c = 0; c < 4; ++c) *(f32x4*)(po + 32 * db + 8 * c + 4 * h) = (f32x4){o[db][4 * c], o[db][4 * c + 1], o[db][4 * c + 2], o[db][4 * c + 3]};
                if (h == 0) ((float*)((unsigned char*)p->out + DP_L))[((size_t)g * M + tok) * 2 + hs] = lt;
            }
        }
    }
}

__device__ __forceinline__ void dcombine_phase(float* dout, bf16* od) {
    const int tid = opaque_tid();
    const float* PO = (const float*)((unsigned char*)dout + DP_O); const float* PL = (const float*)((unsigned char*)dout + DP_L);
    for (int u = blockIdx.x * NTHREADS + tid; u < M * 32; u += gridDim.x * NTHREADS) {
        const int tok = u >> 5, c0 = (u & 31) * 8;
        v4u w = {0u, 0u, 0u, 0u};
        if (c0 < 128) {
            const int hs = c0 >> 6;
            f32x4 a = {0.f, 0.f, 0.f, 0.f}, bq = a; float lsum = 0.f;
#pragma unroll
            for (int g = 0; g < 3; ++g) {
                const float* q = PO + ((size_t)g * M + tok) * 128 + c0;
                a = a + *(const f32x4*)q; bq = bq + *(const f32x4*)(q + 4);
                lsum += PL[((size_t)g * M + tok) * 2 + hs];
            }
            const float inv = 1.0f / lsum;
            w.x = pk2(a[0] * inv, a[1] * inv); w.y = pk2(a[2] * inv, a[3] * inv); w.z = pk2(bq[0] * inv, bq[1] * inv); w.w = pk2(bq[2] * inv, bq[3] * inv);
        }
        *(v4u*)(od + (size_t)tok * 256 + c0) = w;
    }
}

#define XB_TMO      128
#define XB_XCNT(j)  (256  + 64 * (j))
#define XB_XSUB(j)  (1280 + 64 * (j))
#define XB_XGEN(j)  (2304 + 64 * (j))
#define XB_TOP      3328
#define XB_TOPGEN   3392
#define XCD_BAR_WORDS 3456
#define XB_SPIN_CAP (1u << 18)

__device__ __forceinline__ unsigned xb_ld(unsigned* p)              { return __hip_atomic_load(p, __ATOMIC_RELAXED, __HIP_MEMORY_SCOPE_AGENT); }
__device__ __forceinline__ unsigned xb_add(unsigned* p, unsigned v) { return __hip_atomic_fetch_add(p, v, __ATOMIC_RELAXED, __HIP_MEMORY_SCOPE_AGENT); }
__device__ __forceinline__ unsigned xb_xcc_id() { return (unsigned)__builtin_amdgcn_s_getreg((3 << 11) | 20) & 0xFu; }
#define XB_SPIN(cond, bar) do { unsigned _sp = 0; while (cond) { __builtin_amdgcn_s_sleep(1); \
    if ((++_sp & 255u) == 0u) { if (xb_ld(&(bar)[XB_TMO])) break; if (_sp > XB_SPIN_CAP) { atomicAdd(&(bar)[XB_TMO], 1u); break; } } } } while (0)

struct XcdBarrier {
    unsigned* bar; unsigned x;
    volatile LAS unsigned* st;
};

__device__ __forceinline__ XcdBarrier xcd_barrier_post(unsigned* bar, volatile LAS unsigned* st) {
    XcdBarrier b; b.bar = bar; b.x = xb_xcc_id(); b.st = st;
    if (threadIdx.x == 0) (void)xb_add(&bar[XB_XCNT(b.x)], 1u);
    return b;
}
__device__ __forceinline__ void xcd_barrier_complete(unsigned* bar, unsigned x, unsigned& nloc, unsigned& nx) {
    const unsigned G = gridDim.x * gridDim.y * gridDim.z;
    unsigned sum, cnt, mine, sp = 0u;
    for (;;) {
        sum = 0u; cnt = 0u; mine = 0u;
#pragma unroll
        for (unsigned j = 0; j < 16; ++j) { const unsigned c = xb_ld(&bar[XB_XCNT(j)]); sum += c; cnt += (c > 0u) ? 1u : 0u; mine = (j == x) ? c : mine; }
        if (sum == G) break;
        __builtin_amdgcn_s_sleep(1);
        if ((++sp & 255u) == 0u) { if (xb_ld(&bar[XB_TMO])) break; if (sp > XB_SPIN_CAP) { atomicAdd(&bar[XB_TMO], 1u); break; } }
    }
    nloc = mine > 0u ? mine : 1u; nx = cnt > 0u ? cnt : 1u;
}

__device__ __forceinline__ void xcd_barrier(const XcdBarrier& b) {
    asm volatile("s_waitcnt vmcnt(0)" ::: "memory");
    __syncthreads();
    if (threadIdx.x == 0) {
        unsigned* bar = b.bar;
        __builtin_amdgcn_s_waitcnt(0);
        unsigned nloc = b.st[0], nx = b.st[1];
        if (nloc == 0u) { xcd_barrier_complete(bar, b.x, nloc, nx); b.st[0] = nloc; b.st[1] = nx; }
        const unsigned old = xb_add(&bar[XB_XSUB(b.x)], 1u);
        const unsigned gen = old / nloc;
        if (old + 1u == (gen + 1u) * nloc) {
            __builtin_amdgcn_fence(__ATOMIC_RELEASE, "agent");
            asm volatile("s_waitcnt vmcnt(0)" ::: "memory");
            const unsigned og = xb_add(&bar[XB_TOP], 1u);
            const unsigned tg = og / nx;
            if (og + 1u == (tg + 1u) * nx) xb_add(&bar[XB_TOPGEN], 1u);
            else XB_SPIN(xb_ld(&bar[XB_TOPGEN]) == tg, bar);
            __builtin_amdgcn_fence(__ATOMIC_ACQUIRE, "agent");
            xb_add(&bar[XB_XGEN(b.x)], 1u);
            asm volatile("s_waitcnt vmcnt(0)" ::: "memory");
        } else {
            XB_SPIN(xb_ld(&bar[XB_XGEN(b.x)]) == gen, bar);
            __builtin_amdgcn_fence(__ATOMIC_ACQUIRE, "agent");
            asm volatile("s_waitcnt vmcnt(0)" ::: "memory");
        }
    }
    __syncthreads();
}

struct EpiAny {
    static constexpr bool PERM = true, AFTER_DRAIN = false;
    PPtr pp; LAS unsigned char* lds; int kind, layer, bi; float* outf; float scale; const float* rss_in; float* rss_out;
    __device__ __forceinline__ void operator()(AccRef acc, const pg8::Unit& u, int wr, int wc, int fr, int fq) const {
        asm volatile("" : "+v"(fr), "+v"(fq));
        unsigned char* ws = pp->ws; unsigned char* big = ws + WS_BIG;
        LAS float* rst = (LAS float*)(lds + 131072 + 256);
        if (kind == 0 || kind == 2 || kind == 4) {
            const int t = opaque_tid();
            if (t < 256) rst[t] = row_rs(rss_in, u.pm * 256 + t);
            __syncthreads();
        }
        if (kind == 0) { EpiSwiglu E{(bf16*)big, rst}; E(acc, u, wr, wc, fr, fq); }
        else if (kind == 1) { EpiResid E{(bf16*)(ws + WS_HN), outf, scale, rss_out}; E(acc, u, wr, wc, fr, fq); }
        else if (kind == 2) {
            const int l = layer;
            EpiQKV E{big, pp->in[9] + l * 64, pp->in[10] + l * 64, pp->in[13] + l * 64, pp->in[14] + l * 64, pp->in[15] + l * 64, pp->in[16] + l * 64, pp->in[8] + l * 6, (float*)(ws + WS_LOGF), rst};
            E(acc, u, wr, wc, fr, fq);
        }
        else if (kind == 3) { EpiPStore E{(v4u*)(big + B_P)}; E(acc, u, wr, wc, fr, fq); }
        else { EpiGate E{pp->in[7] + (size_t)layer * 4 * D + (size_t)bi * D, (const v4u*)(big + B_P), (v4u*)(big + B_TMP), (bf16*)(big + B_MRG), bi == 0, bi == 3, rst}; E(acc, u, wr, wc, fr, fq); }
    }
};

constexpr int STEPS_PER_LAYER = 16, CW_BAR = 4096;
#ifndef PROBE_STEP
#define PROBE_STEP (-1)
#endif
#ifndef PROBE_SYNCS
#define PROBE_SYNCS 0
#endif
__global__ void __launch_bounds__(NTHREADS, 2) mega_fwd(Params p) {
    extern __shared__ __attribute__((aligned(16))) unsigned char lds_raw[];
    LAS unsigned char* lds = (LAS unsigned char*)lds_raw;
    cg::grid_group grid = cg::this_grid();

    if (blockIdx.x == 0) for (int i = threadIdx.x; i < CW_BAR + XCD_BAR_WORDS; i += NTHREADS) ((unsigned*)(p.ws + WS_CTL))[i] = 0u;
    volatile LAS unsigned* bst = (volatile LAS unsigned*)(lds + LDS_BST);
    if (threadIdx.x < 2) bst[threadIdx.x] = 0u;
    prologue_weights(p, lds);
#ifdef PROBE_PROLOGUE
    prologue_weights(p, lds);
#endif
    norm_phase(p.in[0], (bf16*)(p.ws + WS_HN), (float*)(p.ws + WS_RSP));
    grid.sync();
    (void)xcd_barrier_post((unsigned*)(p.ws + WS_CTL) + CW_BAR, bst);

    constexpr int SPL = STEPS_PER_LAYER + ((PROBE_STEP >= 0) ? 1 : 0);
#pragma unroll 1
    for (int step = 0; step < 2 * SPL; ++step) {
        const int l = step / SPL; int k = step % SPL; bool dry = false;
        if (PROBE_STEP >= 0) { if (k == PROBE_STEP) dry = true; else if (k > PROBE_STEP) k -= 1; }
        PPtr pp = (PPtr)__builtin_amdgcn_kernarg_segment_ptr(); asm volatile("" : "+s"(pp));
        unsigned char* ws = pp->ws;
        unsigned char* wb = ws + WS_W + (size_t)l * W_LAYER;
        unsigned char* big = ws + WS_BIG;
        bf16* HN = (bf16*)(ws + WS_HN);
        float* xres = pp->out;
        float* rssb = (float*)(ws + WS_RSP);
        bool is_att = false, is_comb = false, sync_after = true;
        const bf16* A = HN; const bf16* Bt = (const bf16*)wb; int N = D, K = D;
        EpiAny E; E.pp = pp; E.lds = lds; E.kind = 1; E.layer = l; E.bi = 0; E.outf = nullptr; E.scale = 1.0f; E.rss_in = rssb; E.rss_out = rssb;
        if (k == 0)       { A = HN; Bt = (const bf16*)(wb + W_1T); N = 2 * FF; K = D; E.kind = 0; E.rss_in = rssb; }
        else if (k == 1)  { A = (const bf16*)big; Bt = (const bf16*)(wb + W_2T); N = D; K = FF; E.kind = 1; E.scale = 0.5f; }
        else if (k == 2)  { A = HN; Bt = (const bf16*)(wb + W_INT); N = NQKV; K = D; E.kind = 2; E.rss_in = rssb; }
        else if (k == 3)  { is_att = true; }
        else if (k == 4)  { is_comb = true; }
        else if (k < 13)  {
            const int i = (k - 5) >> 1;
            E.bi = i;
            if (((k - 5) & 1) == 0) {
                const size_t aoff = (i == 0) ? B_QA : (i == 1 ? B_QB : (i == 2 ? B_QC : B_OD));
                const size_t woff = (i == 0) ? WB_A : (i == 1 ? WB_B : (i == 2 ? WB_C : WB_D));
                A = (const bf16*)(big + aoff); Bt = (const bf16*)(wb + W_BRT + woff); N = D; K = (i == 0) ? 512 : (i == 3 ? 256 : 384); E.kind = 3;
            } else {
                A = HN; Bt = (const bf16*)(wb + W_GT) + (size_t)i * D * D; N = D; K = D; E.kind = 4; E.rss_in = rssb;
            }
            sync_after = (k == 12);
        }
        else if (k == 13) { A = (const bf16*)(big + B_MRG); Bt = (const bf16*)(wb + W_OT); N = D; K = D; E.kind = 1; E.scale = 1.0f; }
        else if (k == 14) { A = HN; Bt = (const bf16*)(wb + W_3T); N = 2 * FF; K = D; E.kind = 0; E.rss_in = rssb; }
        else              { A = (const bf16*)big; Bt = (const bf16*)(wb + W_4T); N = D; K = FF; E.kind = 1; E.scale = 0.5f; if (l == 1) E.outf = xres; }

        if (is_comb) {
            dcombine_phase(xres, (bf16*)(big + B_OD));
        } else if (!is_att) {
            if (dry && E.kind == 1) { E.scale = 0.f; E.outf = nullptr; }
            pg8::Gemm g{A, Bt, M, N, K}; pg8::StaticOrder So; So.init(M, N, (int)gridDim.x, (int)blockIdx.x);
            pg8::gemm_phase<EpiAny, pg8::StaticOrder, true, true>(lds, g, So, E);
        } else {
            attention_phase(pp, l, lds, (unsigned*)(ws + WS_CTL) + l + (dry ? 2 : 0), !dry);
        }
        if (step == 2 * SPL - 1) sync_after = false;
        if (dry || sync_after) {
            XcdBarrier xb; xb.bar = (unsigned*)(ws + WS_CTL) + CW_BAR; xb.x = xb_xcc_id(); xb.st = (volatile LAS unsigned*)(lds + LDS_BST);
            int nb = 1;
            if (PROBE_SYNCS > 0 && k == 0) nb += PROBE_SYNCS;
#pragma unroll 1
            for (int i = 0; i < nb; ++i) xcd_barrier(xb);
        }
    }
}

extern "C" void kernel_launch(void* const* d_in, const int* in_sizes, int n_in, void* d_out, int out_size, void* d_ws, size_t ws_size, hipStream_t stream) {
    static int grid = 0;
    if (grid == 0) {
        if (n_in != 22 || out_size != M * D || ws_size < WS_END) { fprintf(stderr, "kernel_launch: unexpected shapes (n_in %d, out %d, ws %zu)\n", n_in, out_size, ws_size); grid = -1; return; }
        int dev = 0, cus = 0, per_cu = 0;
        hipGetDevice(&dev);
        hipDeviceGetAttribute(&cus, hipDeviceAttributeMultiprocessorCount, dev);
        if (hipFuncSetAttribute((const void*)mega_fwd, hipFuncAttributeMaxDynamicSharedMemorySize, LDS_BYTES) != hipSuccess) fprintf(stderr, "kernel_launch: hipFuncSetAttribute failed\n");
        if (hipOccupancyMaxActiveBlocksPerMultiprocessor(&per_cu, (const void*)mega_fwd, NTHREADS, LDS_BYTES) != hipSuccess || per_cu < 1) per_cu = 1;
        (void)hipGetLastError();
        grid = cus * per_cu;
    }
    if (grid < 0) return;
    Params p{};
    for (int i = 0; i < 22; ++i) p.in[i] = (const float*)d_in[i];
    p.out = (float*)d_out; p.ws = (unsigned char*)d_ws;
    for (int l = 0; l < 2; ++l) { const double li = 0.8 - 0.6 * exp(-0.3 * (double)l); p.lam_init[l] = (float)li; p.one_minus_lam_init[l] = (float)(1.0 - li); }
    void* args[] = {&p};
    hipError_t e = hipLaunchCooperativeKernel((const void*)mega_fwd, dim3(grid), dim3(NTHREADS), args, LDS_BYTES, stream);
    if (e != hipSuccess) fprintf(stderr, "cooperative launch failed: %s (grid %d)\n", hipGetErrorString(e), grid);
}
```

```cpp
#include <hip/hip_runtime.h>
#include <hip/hip_cooperative_groups.h>
#include <cstdio>
#include <cstdint>
#include <cmath>
namespace cg = cooperative_groups;
namespace pg8 {
#define PG8_LAS __attribute__((address_space(3)))
typedef unsigned short bf16_t;
typedef short bf16x8 __attribute__((ext_vector_type(8)));
typedef float f32x4 __attribute__((ext_vector_type(4)));
typedef unsigned u32x4 __attribute__((ext_vector_type(4)));
constexpr int BM = 256, BK = 64, HALF = 128, HTB = HALF * BK * 2  , STAGE_BYTES = 8 * HTB, NXCD = 8, WGM = 8;

__host__ __device__ __forceinline__ int lds_byte(int r, int c) { const int st = (r >> 4) * 2 + (c >> 5), rr = r & 15, cc = c & 31, ob = rr * 64 + cc * 2; return st * 1024 + (ob ^ (((ob >> 9) & 1) << 5)); }
__host__ __device__ __forceinline__ void stage_rc(int b, int& R, int& C) { const int st = b / 1024, sb = b % 1024, swz = sb ^ (((sb >> 9) & 1) << 5); R = (st >> 1) * 16 + swz / 64; C = (st & 1) * 32 + (swz % 64) / 2; }
__host__ __device__ __forceinline__ int perm32(int rho) { const int n = rho >> 4, i = rho & 15; return 8 * (i >> 2) + 4 * n + (i & 3); }

struct Unit { int pm, pn; };
struct Gemm { const bf16_t* A; const bf16_t* Bt; int M, N, K; };

struct StaticOrder {
    int nM, nN, nwg, G, c;
    __host__ __device__ void init(int M, int N, int G_, int c_) { nM = M / BM; nN = N / BM; nwg = nM * nN; G = G_; c = c_; }
    __host__ __device__ bool next(int i, Unit& u) const {
        const long L = (long)i * G + c; if (L >= nwg) return false;
        int wgid = (int)L; { const int q = nwg / NXCD, r = nwg % NXCD, xcd = wgid % NXCD, off = wgid / NXCD; wgid = (xcd < r ? xcd * (q + 1) : r * (q + 1) + (xcd - r) * q) + off; }
        const int nig = WGM * nN, gid = wgid / nig, fm = gid * WGM, gsz = (nM - fm) < WGM ? (nM - fm) : WGM;
        u.pm = fm + ((wgid % nig) % gsz); u.pn = (wgid % nig) / gsz; return true;
    }
    __device__ __forceinline__ void a_ready(const Unit&) const {}
    __device__ __forceinline__ void done(const Unit&) const {}
};
__device__ __forceinline__ unsigned cvt_pk_bf16(float lo, float hi) { unsigned r; asm volatile("v_cvt_pk_bf16_f32 %0, %1, %2" : "=v"(r) : "v"(lo), "v"(hi)); return r; }
template <class Epi, class Sched, bool ALIGN_EPI = false, bool SP2 = false>
__device__ __forceinline__ void gemm_phase(PG8_LAS unsigned char* lds, const Gemm g, const Sched& S, const Epi& E) {
    int tid_ = threadIdx.x; asm volatile("" : "+v"(tid_));
    const int tid = tid_, wid = __builtin_amdgcn_readfirstlane(tid >> 6), lane = tid & 63, wr = wid >> 2, wc = wid & 3, fr = lane & 15, fq = lane >> 4;
    const int K = g.K, nt = K / BK;
    unsigned voffA, voffB;
    { int R, C; stage_rc(tid * 16, R, C); const int Rb = Epi::PERM ? ((R & ~31) + perm32(R & 31)) : R;
      voffA = (unsigned)(R * K + C) * 2u; voffB = (unsigned)(Rb * K + C) * 2u; }
    const size_t r64 = (size_t)64 * K * 2;
    const size_t kstep = (size_t)(BK * 2);
    const size_t hstep = (size_t)HALF * K * 2;
    const size_t tstep = 2 * hstep;
    const unsigned ldsw = (unsigned)wid * 1024u;
    const int aoff = lds_byte(wr * 64 + fr, fq * 8), boff = lds_byte(wc * 32 + fr, fq * 8);
#define PG8_SA(b, h) (((b) * 2 + (h)) * HTB)
#define PG8_SB(b, h) ((4 + (b) * 2 + (h)) * HTB)
#define PG8_STAGE(bufoff, gbase, voff) do { _Pragma("unroll") for (int _i = 0; _i < 2; ++_i) \
        __builtin_amdgcn_global_load_lds((const unsigned*)((const char*)(gbase) + (size_t)_i * r64 + (voff)), (PG8_LAS unsigned*)(lds + (bufoff) + ldsw + _i * 8192), 16, 0, 0); } while (0)
#define PG8_LDA(dst, b, h) do { _Pragma("unroll") for (int m = 0; m < 4; ++m) _Pragma("unroll") for (int k = 0; k < 2; ++k) dst[m][k] = *(const PG8_LAS bf16x8*)(lds + PG8_SA(b, h) + aoff + m * 2048 + k * 1024); } while (0)
#define PG8_LDB(dst, b, h) do { _Pragma("unroll") for (int n = 0; n < 2; ++n) _Pragma("unroll") for (int k = 0; k < 2; ++k) dst[n][k] = *(const PG8_LAS bf16x8*)(lds + PG8_SB(b, h) + boff + n * 2048 + k * 1024); } while (0)
#define PG8_MMA(ai, bj, At, Bt) do { __builtin_amdgcn_s_setprio(1); _Pragma("unroll") for (int m = 0; m < 4; ++m) _Pragma("unroll") for (int n = 0; n < 2; ++n) _Pragma("unroll") for (int k = 0; k < 2; ++k) \
        acc[ai][bj][m][n] = __builtin_amdgcn_mfma_f32_16x16x32_bf16(Bt[n][k], At[m][k], acc[ai][bj][m][n], 0, 0, 0); __builtin_amdgcn_s_setprio(0); } while (0)
#define PG8_WAIT_V(n) asm volatile("s_waitcnt vmcnt(" #n ")" ::: "memory")
#define PG8_WAIT_L(n) asm volatile("s_waitcnt lgkmcnt(" #n ")" ::: "memory")
#define PG8_BAR __builtin_amdgcn_s_barrier()
#define PG8_SCHED __builtin_amdgcn_sched_barrier(0)
    Unit cur, nxt; int ui = 0;
    if (!S.next(0, cur)) return;
    f32x4 acc[2][2][4][2];
#pragma unroll
    for (int a = 0; a < 2; ++a)
#pragma unroll
        for (int b = 0; b < 2; ++b)
#pragma unroll
            for (int m = 0; m < 4; ++m)
#pragma unroll
                for (int n = 0; n < 2; ++n) acc[a][b][m][n] = (f32x4){0.f, 0.f, 0.f, 0.f};
    bf16x8 At[4][2], B0[2][2], B1[2][2];
    const char* cA = (const char*)g.A + (size_t)cur.pm * tstep; const char* cB = (const char*)g.Bt + (size_t)cur.pn * tstep;
    S.a_ready(cur);
    if constexpr (SP2) {
        PG8_STAGE(PG8_SB(0, 0), cB, voffB); PG8_STAGE(PG8_SB(0, 1), cB + hstep, voffB); PG8_STAGE(PG8_SA(0, 0), cA, voffA); PG8_STAGE(PG8_SA(0, 1), cA + hstep, voffA);
        if (wr == 1) PG8_BAR;
        PG8_WAIT_V(2); PG8_BAR;
        PG8_STAGE(PG8_SB(1, 0), cB + kstep, voffB); PG8_STAGE(PG8_SA(1, 0), cA + kstep, voffA); PG8_STAGE(PG8_SB(1, 1), cB + hstep + kstep, voffB);
        PG8_WAIT_V(6); PG8_BAR;
    } else {
        PG8_STAGE(PG8_SB(0, 0), cB, voffB); PG8_STAGE(PG8_SA(0, 0), cA, voffA); PG8_STAGE(PG8_SB(0, 1), cB + hstep, voffB); PG8_STAGE(PG8_SA(0, 1), cA + hstep, voffA);
        if (wr == 1) PG8_BAR;
        PG8_WAIT_V(4); PG8_BAR;
        PG8_STAGE(PG8_SB(1, 0), cB + kstep, voffB); PG8_STAGE(PG8_SA(1, 0), cA + kstep, voffA); PG8_STAGE(PG8_SB(1, 1), cB + hstep + kstep, voffB);
        PG8_WAIT_V(6); PG8_BAR;
    }
    for (;;) {
        const bool has_next = S.next(ui + 1, nxt);
        const char* nA = has_next ? (const char*)g.A + (size_t)nxt.pm * tstep : cA; const char* nB = has_next ? (const char*)g.Bt + (size_t)nxt.pn * tstep : cB;
        for (int t = 0; t < nt; t += 2) {
            const bool last = (t == nt - 2);
            const char* a1 = cA + (size_t)(t + 1) * kstep;
            const char* a2 = last ? nA : cA + (size_t)(t + 2) * kstep; const char* b2 = last ? nB : cB + (size_t)(t + 2) * kstep;
            const char* a3 = a2 + kstep; const char* b3 = b2 + kstep;
            if (last && has_next) S.a_ready(nxt);
            if constexpr (SP2) {
            PG8_LDB(B0, 0, 0); PG8_LDB(B1, 0, 1); PG8_SCHED; PG8_LDA(At, 0, 0); PG8_STAGE(PG8_SA(1, 1), a1 + hstep, voffA);
            PG8_WAIT_V(8); PG8_WAIT_L(0); PG8_BAR; PG8_MMA(0, 0, At, B0); PG8_MMA(0, 1, At, B1); PG8_BAR; PG8_SCHED;
            PG8_LDA(At, 0, 1); PG8_STAGE(PG8_SB(0, 0), b2, voffB); PG8_STAGE(PG8_SB(0, 1), b2 + hstep, voffB); PG8_STAGE(PG8_SA(0, 0), a2, voffA);
            PG8_WAIT_V(8); PG8_WAIT_L(0); PG8_BAR; PG8_MMA(1, 0, At, B0); PG8_MMA(1, 1, At, B1); PG8_BAR; PG8_SCHED;
            PG8_LDB(B0, 1, 0); PG8_LDB(B1, 1, 1); PG8_SCHED; PG8_LDA(At, 1, 0); PG8_STAGE(PG8_SA(0, 1), a2 + hstep, voffA);
            PG8_WAIT_V(8); PG8_WAIT_L(0); PG8_BAR; PG8_MMA(0, 0, At, B0); PG8_MMA(0, 1, At, B1); PG8_BAR; PG8_SCHED;
            PG8_LDA(At, 1, 1); PG8_STAGE(PG8_SB(1, 0), b3, voffB); PG8_STAGE(PG8_SB(1, 1), b3 + hstep, voffB); PG8_STAGE(PG8_SA(1, 0), a3, voffA);
            PG8_WAIT_V(8); PG8_WAIT_L(0); PG8_BAR; PG8_MMA(1, 0, At, B0); PG8_MMA(1, 1, At, B1); PG8_BAR; PG8_SCHED;
            } else {
            PG8_LDB(B0, 0, 0); PG8_SCHED; PG8_LDA(At, 0, 0); PG8_STAGE(PG8_SA(1, 1), a1 + hstep, voffA);
            PG8_WAIT_L(8); PG8_BAR; PG8_WAIT_L(0); PG8_MMA(0, 0, At, B0); PG8_BAR; PG8_SCHED;
            PG8_LDB(B1, 0, 1); PG8_STAGE(PG8_SB(0, 0), b2, voffB);
            PG8_BAR; PG8_WAIT_L(0); PG8_MMA(0, 1, At, B1); PG8_BAR;
            PG8_LDA(At, 0, 1); PG8_STAGE(PG8_SA(0, 0), a2, voffA);
            PG8_BAR; PG8_WAIT_L(0); PG8_MMA(1, 0, At, B0); PG8_BAR; PG8_SCHED;
            PG8_STAGE(PG8_SB(0, 1), b2 + hstep, voffB);
            PG8_WAIT_V(6); PG8_BAR; PG8_MMA(1, 1, At, B1); PG8_BAR;
            PG8_LDB(B0, 1, 0); PG8_SCHED; PG8_LDA(At, 1, 0); PG8_STAGE(PG8_SA(0, 1), a2 + hstep, voffA);
            PG8_WAIT_L(8); PG8_BAR; PG8_WAIT_L(0); PG8_MMA(0, 0, At, B0); PG8_BAR; PG8_SCHED;
            PG8_LDB(B1, 1, 1); PG8_STAGE(PG8_SB(1, 0), b3, voffB);
            PG8_BAR; PG8_WAIT_L(0); PG8_MMA(0, 1, At, B1); PG8_BAR;
            PG8_LDA(At, 1, 1); PG8_STAGE(PG8_SA(1, 0), a3, voffA);
            PG8_BAR; PG8_WAIT_L(0); PG8_MMA(1, 0, At, B0); PG8_BAR; PG8_SCHED;
            PG8_STAGE(PG8_SB(1, 1), b3 + hstep, voffB);
            PG8_WAIT_V(6); PG8_BAR; PG8_MMA(1, 1, At, B1); PG8_BAR;
            }
        }
        if constexpr (ALIGN_EPI) { if (wr == 0) PG8_BAR; }
        if constexpr (!Epi::AFTER_DRAIN) { E(acc, cur, wr, wc, fr, fq); S.done(cur); }
        if (!has_next) break;
#pragma unroll
        for (int a = 0; a < 2; ++a)
#pragma unroll
            for (int b = 0; b < 2; ++b)
#pragma unroll
                for (int m = 0; m < 4; ++m)
#pragma unroll
                    for (int n = 0; n < 2; ++n) acc[a][b][m][n] = (f32x4){0.f, 0.f, 0.f, 0.f};
        cur = nxt; cA = nA; cB = nB; ++ui;
        if constexpr (ALIGN_EPI) { if (wr == 1) PG8_BAR; }
    }
    PG8_WAIT_V(0);
    if constexpr (!ALIGN_EPI) { if (wr == 0) PG8_BAR; }
    PG8_BAR;
    if constexpr (Epi::AFTER_DRAIN) { E.fused(acc, cur, wr, wc, fr, fq, lds, wid, lane); S.done(cur); }
#undef PG8_SA
#undef PG8_SB
#undef PG8_STAGE
#undef PG8_LDA
#undef PG8_LDB
#undef PG8_MMA
#undef PG8_WAIT_V
#undef PG8_WAIT_L
#undef PG8_BAR
#undef PG8_SCHED
}
}

#define GAS __attribute__((address_space(1)))
#define LAS __attribute__((address_space(3)))
typedef unsigned short bf16;
typedef unsigned v4u __attribute__((ext_vector_type(4)));
typedef unsigned v2u __attribute__((ext_vector_type(2)));
typedef float f32x4 __attribute__((ext_vector_type(4)));
typedef float f32x16 __attribute__((ext_vector_type(16)));
typedef short bf16x8 __attribute__((ext_vector_type(8)));
typedef __bf16 bf16x2_t __attribute__((ext_vector_type(2)));
typedef float f32x2_t __attribute__((ext_vector_type(2)));
#define LDS_WAIT() asm volatile("s_waitcnt lgkmcnt(0)" ::: "memory")
#define MFMA32(a, b, c) __builtin_amdgcn_mfma_f32_32x32x16_bf16((a), (b), (c), 0, 0, 0)

constexpr int M = 32768, D = 1024, S = 2048, NBATCH = 16, FF = 2816, DIN = 9094, NQKV = 5120;
constexpr float LOG2E = 1.4426950408889634f, LN2 = 0.6931471805599453f;
constexpr float QSCALE = 0.125f * LOG2E;
constexpr float RMS_EPS = 1e-6f;
constexpr size_t MiB = 1u << 20;
constexpr size_t WS_CTL = 0, WS_LOGF = 1 * MiB, WS_W = 2 * MiB, W_LAYER = 56 * MiB, WS_HN = 114 * MiB, WS_BIG = 178 * MiB, WS_RSP = 507 * MiB, WS_END = 509 * MiB;
constexpr size_t W_1T = 0, W_2T = 11 * MiB, W_INT = 16 * MiB + MiB / 2, W_GT = 26 * MiB + MiB / 2, W_BRT = 34 * MiB + MiB / 2, W_OT = 37 * MiB + MiB / 2,
                 W_3T = 39 * MiB + MiB / 2, W_4T = 50 * MiB + MiB / 2;
constexpr size_t WB_A = 0, WB_B = 1 * MiB, WB_C = 1 * MiB + 3 * MiB / 4, WB_D = 2 * MiB + MiB / 2;
constexpr size_t B_QA = 0, B_QB = 32 * MiB, B_QC = 56 * MiB, B_OD = 80 * MiB, B_KA = 96 * MiB, B_VA = 128 * MiB, B_KB = 160 * MiB, B_VB = 184 * MiB,
                 B_KC = 208 * MiB, B_VC = 232 * MiB, B_QD = 256 * MiB, B_KD = 280 * MiB, B_VD = 304 * MiB;
constexpr size_t B_P = 96 * MiB, B_TMP = 160 * MiB, B_MRG = 224 * MiB;
constexpr int LDS_BYTES = 156672, LDS_BST = 155648 + 64;
constexpr int NTHREADS = 512;

struct Params;
typedef const __attribute__((address_space(4))) Params* PPtr;
struct Params {
    const float* in[22];
    float* out;
    unsigned char* ws;
    float lam_init[2];
    float one_minus_lam_init[2];
};

__device__ __forceinline__ int opaque_tid() { int t = threadIdx.x; asm volatile("" : "+v"(t)); return t; }
__device__ __forceinline__ unsigned f2bf(float f) { unsigned u = __builtin_bit_cast(unsigned, f); return (u + 0x7fffu + ((u >> 16) & 1u)) >> 16; }
__device__ __forceinline__ unsigned pk2(float lo, float hi) { f32x2_t v = {lo, hi}; bf16x2_t b = __builtin_convertvector(v, bf16x2_t); return __builtin_bit_cast(unsigned, b); }
__device__ __forceinline__ float bflo(unsigned w) { return __builtin_bit_cast(float, w << 16); }
__device__ __forceinline__ float bfhi(unsigned w) { return __builtin_bit_cast(float, w & 0xffff0000u); }
__device__ __forceinline__ float fexp2(float x) { return __builtin_amdgcn_exp2f(x); }
__device__ __forceinline__ float flog2(float x) { return __builtin_amdgcn_logf(x); }
__device__ __forceinline__ float sigmoidf_(float x) { return __builtin_amdgcn_rcpf(1.0f + fexp2(-x * LOG2E)); }
__device__ __forceinline__ float row_rs(const float* rsp, int row) {
    const f32x4* q = (const f32x4*)(rsp + (size_t)row * 16);
    const f32x4 a = q[0], b = q[1], c = q[2], d = q[3];
    const float s = ((a[0] + a[1]) + (a[2] + a[3])) + ((b[0] + b[1]) + (b[2] + b[3])) + ((c[0] + c[1]) + (c[2] + c[3])) + ((d[0] + d[1]) + (d[2] + d[3]));
    return rsqrtf(s * (1.0f / 1024.0f) + 1e-6f);
}
__device__ __forceinline__ float wave_sum(float v) {
#pragma unroll
    for (int o = 1; o < 64; o <<= 1) v += __shfl_xor(v, o);
    return v;
}

typedef const pg8::f32x4 (&AccRef)[2][2][4][2];

struct EpiSwiglu {
    static constexpr bool PERM = true, AFTER_DRAIN = false;
    bf16* U; const LAS float* rst;
    __device__ __forceinline__ void operator()(AccRef acc, const pg8::Unit& u, int wr, int wc, int fr, int fq) const {
        const int row0 = u.pm * 256 + wr * 64 + fr, col0 = u.pn * 128 + wc * 32 + 8 * fq;
#pragma unroll
        for (int ai = 0; ai < 2; ++ai)
#pragma unroll
            for (int m = 0; m < 4; ++m) {
                const int row = row0 + ai * 128 + m * 16;
                const float rs = rst[row & 255];
                float v[8];
#pragma unroll
                for (int n = 0; n < 2; ++n)
#pragma unroll
                    for (int j = 0; j < 4; ++j) { const float g = acc[ai][0][m][n][j] * rs, up = acc[ai][1][m][n][j] * rs; v[4 * n + j] = g * sigmoidf_(g) * up; }
                v4u w; w.x = pk2(v[0], v[1]); w.y = pk2(v[2], v[3]); w.z = pk2(v[4], v[5]); w.w = pk2(v[6], v[7]);
                *(v4u*)(U + (size_t)row * FF + col0) = w;
            }
    }
};

struct EpiResid {
    static constexpr bool PERM = true, AFTER_DRAIN = false;
    bf16* xb; float* outf; float scale; float* rss;
    __device__ __forceinline__ void operator()(AccRef acc, const pg8::Unit& u, int wr, int wc, int fr, int fq) const {
        const int row0 = u.pm * 256 + wr * 64 + fr, col0 = u.pn * 256 + wc * 32 + 8 * fq;
#pragma unroll
        for (int ai = 0; ai < 2; ++ai) {
            v4u xw[4][2];
#pragma unroll
            for (int m = 0; m < 4; ++m)
#pragma unroll
                for (int bj = 0; bj < 2; ++bj) xw[m][bj] = *(const v4u*)(xb + (size_t)(row0 + ai * 128 + m * 16) * D + col0 + bj * 128);
#pragma unroll
            for (int m = 0; m < 4; ++m) {
                const int row = row0 + ai * 128 + m * 16;
                float ss = 0.f;
#pragma unroll
                for (int bj = 0; bj < 2; ++bj) {
                    const size_t p = (size_t)row * D + col0 + bj * 128;
                    const v4u w0 = xw[m][bj];
                    f32x4 a = {bflo(w0.x), bfhi(w0.x), bflo(w0.y), bfhi(w0.y)}, b = {bflo(w0.z), bfhi(w0.z), bflo(w0.w), bfhi(w0.w)};
                    a = a + acc[ai][bj][m][0] * scale; b = b + acc[ai][bj][m][1] * scale;
                    if (outf) { *(f32x4*)(outf + p) = a; *(f32x4*)(outf + p + 4) = b; }
                    else {
                        ss += (a[0] * a[0] + a[1] * a[1]) + (a[2] * a[2] + a[3] * a[3]) + (b[0] * b[0] + b[1] * b[1]) + (b[2] * b[2] + b[3] * b[3]);
                        v4u w; w.x = pk2(a[0], a[1]); w.y = pk2(a[2], a[3]); w.z = pk2(b[0], b[1]); w.w = pk2(b[2], b[3]);
                        *(v4u*)(xb + p) = w;
                    }
                }
                if (!outf) {
                    ss += __shfl_xor(ss, 16); ss += __shfl_xor(ss, 32);
                    if (fq == 0) rss[(size_t)row * 16 + u.pn * 4 + wc] = ss;
                }
            }
        }
    }
};

struct EpiQKV {
    static constexpr bool PERM = true, AFTER_DRAIN = false;
    unsigned char* big; const float *aq, *ak, *cq, *ck, *dq, *dk, *fb; float* logf; const LAS float* rst;
    __device__ __forceinline__ void operator()(AccRef acc, const pg8::Unit& u, int wr, int wc, int fr, int fq) const {
        const int G = u.pn * 4 + wc;
        if (G >= 79) return;
        const int row0 = u.pm * 256 + wr * 64 + fr;
        if (G == 78) {
            if (fq == 0) {
#pragma unroll
                for (int ai = 0; ai < 2; ++ai)
#pragma unroll
                    for (int m = 0; m < 4; ++m) {
                        const int row = row0 + ai * 128 + m * 16;
                        const float rsr = rst[row & 255];
#pragma unroll
                        for (int e = 0; e < 6; ++e) {
                            const float x = acc[ai][0][m][e >> 2][e & 3] * rsr + fb[e];
                            const float ls = fminf(x, 0.f) - LN2 * flog2(1.0f + fexp2(-fabsf(x) * LOG2E));
                            logf[(size_t)row * 8 + e] = ls;
                        }
                    }
            }
            return;
        }
        size_t off; int pitch, lg; const float* gain = nullptr; float sc = 1.f;
        if (G < 8)       { off = B_QA; pitch = 512; lg = G;      gain = aq; sc = QSCALE; }
        else if (G < 16) { off = B_KA; pitch = 512; lg = G - 8;  gain = ak; }
        else if (G < 24) { off = B_VA; pitch = 512; lg = G - 16; }
        else if (G < 30) { off = B_QB; pitch = 384; lg = G - 24; sc = QSCALE; }
        else if (G < 36) { off = B_KB; pitch = 384; lg = G - 30; }
        else if (G < 42) { off = B_VB; pitch = 384; lg = G - 36; }
        else if (G < 48) { off = B_QC; pitch = 384; lg = G - 42; gain = cq; sc = QSCALE; }
        else if (G < 54) { off = B_KC; pitch = 384; lg = G - 48; gain = ck; }
        else if (G < 60) { off = B_VC; pitch = 384; lg = G - 54; }
        else if (G < 66) { off = B_QD; pitch = 384; lg = G - 60; gain = dq; sc = QSCALE; }
        else if (G < 72) { off = B_KD; pitch = 384; lg = G - 66; gain = dk; }
        else             { off = B_VD; pitch = 384; lg = G - 72; }
        bf16* dst = (bf16*)(big + off) + lg * 64 + 8 * fq;
        f32x4 gv[2][2];
#pragma unroll
        for (int bj = 0; bj < 2; ++bj)
#pragma unroll
            for (int n = 0; n < 2; ++n) {
                f32x4 g4 = {1.f, 1.f, 1.f, 1.f};
                if (gain) g4 = *(const f32x4*)(gain + 32 * bj + 8 * fq + 4 * n);
                gv[bj][n] = g4 * sc;
            }
#pragma unroll
        for (int ai = 0; ai < 2; ++ai)
#pragma unroll
            for (int m = 0; m < 4; ++m) {
                const int row = row0 + ai * 128 + m * 16;
                const float rsr = rst[row & 255];
                f32x4 xv[2][2];
#pragma unroll
                for (int bj = 0; bj < 2; ++bj)
#pragma unroll
                    for (int n = 0; n < 2; ++n) xv[bj][n] = acc[ai][bj][m][n] * rsr;
                float rs = 1.f;
                if (gain) {
                    float ss = 0.f;
#pragma unroll
                    for (int bj = 0; bj < 2; ++bj)
#pragma unroll
                        for (int n = 0; n < 2; ++n) { const f32x4 x = xv[bj][n]; ss += (x[0] * x[0] + x[1] * x[1]) + (x[2] * x[2] + x[3] * x[3]); }
                    ss += __shfl_xor(ss, 16); ss += __shfl_xor(ss, 32);
                    rs = rsqrtf(ss * (1.0f / 64.0f) + RMS_EPS);
                }
#pragma unroll
                for (int bj = 0; bj < 2; ++bj) {
                    const f32x4 v0 = xv[bj][0] * rs * gv[bj][0], v1 = xv[bj][1] * rs * gv[bj][1];
                    v4u w; w.x = pk2(v0[0], v0[1]); w.y = pk2(v0[2], v0[3]); w.z = pk2(v1[0], v1[1]); w.w = pk2(v1[2], v1[3]);
                    *(v4u*)(dst + (size_t)row * pitch + 32 * bj) = w;
                }
            }
    }
};

struct EpiPStore {
    static constexpr bool PERM = true, AFTER_DRAIN = false;
    v4u* P;
    __device__ __forceinline__ void operator()(AccRef acc, const pg8::Unit& u, int wr, int wc, int fr, int fq) const {
        v4u* base = P + (size_t)(u.pm * 4 + u.pn) * 16 * NTHREADS + opaque_tid();
#pragma unroll
        for (int ai = 0; ai < 2; ++ai)
#pragma unroll
            for (int bj = 0; bj < 2; ++bj)
#pragma unroll
                for (int m = 0; m < 4; ++m) {
                    const f32x4 v0 = acc[ai][bj][m][0], v1 = acc[ai][bj][m][1];
                    v4u w; w.x = pk2(v0[0], v0[1]); w.y = pk2(v0[2], v0[3]); w.z = pk2(v1[0], v1[1]); w.w = pk2(v1[2], v1[3]);
                    base[(size_t)((ai * 2 + bj) * 4 + m) * NTHREADS] = w;
                    }
    }
};

struct EpiGate {
    static constexpr bool PERM = true, AFTER_DRAIN = false;
    const float* gb; const v4u* P; v4u* TMP; bf16* MRG; int first, last; const LAS float* rst;
    __device__ __forceinline__ void operator()(AccRef acc, const pg8::Unit& u, int wr, int wc, int fr, int fq) const {
        const size_t ub = (size_t)(u.pm * 4 + u.pn) * 16 * NTHREADS + opaque_tid();
        const int row0 = u.pm * 256 + wr * 64 + fr, col0 = u.pn * 256 + wc * 32 + 8 * fq;
#pragma unroll
        for (int bj = 0; bj < 2; ++bj) {
            const f32x4 bv0 = *(const f32x4*)(gb + col0 + bj * 128), bv1 = *(const f32x4*)(gb + col0 + bj * 128 + 4);
#pragma unroll
            for (int ai = 0; ai < 2; ++ai) {
                v4u pw4[4], tw4[4];
#pragma unroll
                for (int m = 0; m < 4; ++m) {
                    const size_t ci = ub + (size_t)((ai * 2 + bj) * 4 + m) * NTHREADS;
                    pw4[m] = P[ci];
                    if (!first) tw4[m] = TMP[ci]; else tw4[m] = (v4u){0u, 0u, 0u, 0u};
                }
#pragma unroll
                for (int m = 0; m < 4; ++m) {
                    const size_t ci = ub + (size_t)((ai * 2 + bj) * 4 + m) * NTHREADS;
                    const v4u pw = pw4[m], tw = tw4[m];
                    const float rs = rst[(row0 + ai * 128 + m * 16) & 255];
                    float v[8];
                    v[0] = sigmoidf_(acc[ai][bj][m][0][0] * rs + bv0[0]) * bflo(pw.x); v[1] = sigmoidf_(acc[ai][bj][m][0][1] * rs + bv0[1]) * bfhi(pw.x);
                    v[2] = sigmoidf_(acc[ai][bj][m][0][2] * rs + bv0[2]) * bflo(pw.y); v[3] = sigmoidf_(acc[ai][bj][m][0][3] * rs + bv0[3]) * bfhi(pw.y);
                    v[4] = sigmoidf_(acc[ai][bj][m][1][0] * rs + bv1[0]) * bflo(pw.z); v[5] = sigmoidf_(acc[ai][bj][m][1][1] * rs + bv1[1]) * bfhi(pw.z);
                    v[6] = sigmoidf_(acc[ai][bj][m][1][2] * rs + bv1[2]) * bflo(pw.w); v[7] = sigmoidf_(acc[ai][bj][m][1][3] * rs + bv1[3]) * bfhi(pw.w);
                    v[0] += bflo(tw.x); v[1] += bfhi(tw.x); v[2] += bflo(tw.y); v[3] += bfhi(tw.y);
                    v[4] += bflo(tw.z); v[5] += bfhi(tw.z); v[6] += bflo(tw.w); v[7] += bfhi(tw.w);
                    v4u w; w.x = pk2(v[0], v[1]); w.y = pk2(v[2], v[3]); w.z = pk2(v[4], v[5]); w.w = pk2(v[6], v[7]);
                    if (!last) TMP[ci] = w;
                    else *(v4u*)(MRG + (size_t)(row0 + ai * 128 + m * 16) * D + col0 + bj * 128) = w;
                }
            }
        }
    }
};

__device__ __forceinline__ void tr_item(const float* src, int ldw, int k0, int n0, bf16* dst, int ldt, int drow0, int dk0, LAS float* scr, int lane, const float* gk = nullptr) {
#pragma unroll 8
    for (int i = 0; i < 32; ++i) { const int kk = 2 * i + (lane >> 5); scr[kk * 33 + (lane & 31)] = src[(size_t)(k0 + kk) * ldw + n0 + (lane & 31)]; }
    LDS_WAIT(); asm volatile("" ::: "memory");
    const int c = lane & 7;
    f32x4 g0 = {1.f, 1.f, 1.f, 1.f}, g1 = g0;
    if (gk) { g0 = *(const f32x4*)(gk + k0 + 8 * c); g1 = *(const f32x4*)(gk + k0 + 8 * c + 4); }
#pragma unroll
    for (int j = 0; j < 4; ++j) {
        const int n = (lane >> 3) + 8 * j; const LAS float* sp = scr + (8 * c) * 33 + n;
        v4u o; o.x = pk2(sp[0 * 33] * g0[0], sp[1 * 33] * g0[1]); o.y = pk2(sp[2 * 33] * g0[2], sp[3 * 33] * g0[3]);
        o.z = pk2(sp[4 * 33] * g1[0], sp[5 * 33] * g1[1]); o.w = pk2(sp[6 * 33] * g1[2], sp[7 * 33] * g1[3]);
        *(v4u*)(dst + (size_t)(drow0 + n) * ldt + dk0 + 8 * c) = o;
    }
    LDS_WAIT(); asm volatile("" ::: "memory");
}

constexpr int NJ1 = 2816, NJ2 = 1408, NJ3 = 2496, NJ4 = 2048, NJ5A = 256, NJ5B = 192, NJ5C = 192, NJ5D = 64, NJ6 = 512;
constexpr int NPL = NJ1 + NJ2 + NJ3 + NJ4 + NJ5A + NJ5B + NJ5C + NJ5D + NJ6 + NJ1 + NJ2;

__device__ __forceinline__ void ffn_in_item(const float* w, bf16* dst, int r, LAS float* scr, int lane, const float* gk) {
    const int kb = r / 176, nb = r % 176, c0 = 32 * nb;
    const int drow = (c0 < FF) ? 256 * (c0 / 128) + (c0 % 128) : 256 * ((c0 - FF) / 128) + 128 + ((c0 - FF) % 128);
    tr_item(w, 2 * FF, 64 * kb, c0, dst, D, drow, 64 * kb, scr, lane, gk);
}
__device__ __forceinline__ void plain_item(const float* w, int ldw, int krow0, bf16* dst, int ldt, int r, LAS float* scr, int lane) {
    const int kb = r >> 5, nb = r & 31;
    tr_item(w, ldw, krow0 + 64 * kb, 32 * nb, dst, ldt, 32 * nb, 64 * kb, scr, lane);
}

__device__ __forceinline__ void prologue_weights(const Params& p, LAS unsigned char* lds) {
    const int tid = threadIdx.x, lane = tid & 63, wave = tid >> 6;
    LAS float* scr = (LAS float*)(lds + wave * 16384);
    const int gw = blockIdx.x * 8 + wave, NGW = gridDim.x * 8;
    for (int it = gw; it < 2 * NPL; it += NGW) {
        const int l = it / NPL; int r = it % NPL;
        unsigned char* wb = p.ws + WS_W + (size_t)l * W_LAYER;
        if (r < NJ1) { ffn_in_item(p.in[3] + (size_t)l * D * 2 * FF, (bf16*)(wb + W_1T), r, scr, lane, p.in[2] + (size_t)l * D); continue; } r -= NJ1;
        if (r < NJ2) { plain_item(p.in[4] + (size_t)l * FF * D, D, 0, (bf16*)(wb + W_2T), FF, r, scr, lane); continue; } r -= NJ2;
        if (r < NJ3) {
            const int kb = r / 156, nb = r % 156, L0 = 32 * nb, n0 = (L0 < 3840) ? L0 : L0 + 6;
            const int drow = 256 * (L0 >> 8) + 128 * ((L0 & 63) >> 5) + 32 * ((L0 >> 6) & 3);
            tr_item(p.in[6] + (size_t)l * D * DIN, DIN, 64 * kb, n0, (bf16*)(wb + W_INT), D, drow, 64 * kb, scr, lane, p.in[5] + (size_t)l * D); continue; } r -= NJ3;
        if (r < NJ4) {
            const int kb = r >> 7, nb = r & 127;
            tr_item(p.in[6] + (size_t)l * D * DIN, DIN, 64 * kb, 4998 + 32 * nb, (bf16*)(wb + W_GT), D, 32 * nb, 64 * kb, scr, lane, p.in[5] + (size_t)l * D); continue; } r -= NJ4;
        const float* wbr = p.in[17] + (size_t)l * 1408 * D;
        if (r < NJ5A) { plain_item(wbr, D, 0, (bf16*)(wb + W_BRT + WB_A), 512, r, scr, lane); continue; } r -= NJ5A;
        if (r < NJ5B) { plain_item(wbr, D, 512, (bf16*)(wb + W_BRT + WB_B), 384, r, scr, lane); continue; } r -= NJ5B;
        if (r < NJ5C) { plain_item(wbr, D, 896, (bf16*)(wb + W_BRT + WB_C), 384, r, scr, lane); continue; } r -= NJ5C;
        if (r < NJ5D) { plain_item(wbr, D, 1280, (bf16*)(wb + W_BRT + WB_D), 256, r, scr, lane); continue; } r -= NJ5D;
        if (r < NJ6) { plain_item(p.in[18] + (size_t)l * D * D, D, 0, (bf16*)(wb + W_OT), D, r, scr, lane); continue; } r -= NJ6;
        if (r < NJ1) { ffn_in_item(p.in[20] + (size_t)l * D * 2 * FF, (bf16*)(wb + W_3T), r, scr, lane, p.in[19] + (size_t)l * D); continue; } r -= NJ1;
        plain_item(p.in[21] + (size_t)l * FF * D, D, 0, (bf16*)(wb + W_4T), FF, r, scr, lane);
    }
    const int gt = blockIdx.x * NTHREADS + tid, NGT = gridDim.x * NTHREADS;
    for (int i = gt; i < 2 * 131072; i += NGT) {
        const int l = i >> 17, q = i & 131071;
        unsigned char* wb = p.ws + WS_W + (size_t)l * W_LAYER;
        { const int idx = q >> 10, k = q & 1023, R = 4864 + (idx >> 6) * 128 + 64 + (idx & 63), e = R - 4928;
          float v = 0.f; if (e >= 0 && e < 6) v = p.in[6][(size_t)l * D * DIN + (size_t)k * DIN + 3840 + e] * p.in[5][(size_t)l * D + k];
          ((bf16*)(wb + W_INT))[(size_t)R * D + k] = (bf16)f2bf(v); }
        { const int row = q >> 7, col = 128 + (q & 127); ((bf16*)(wb + W_BRT + WB_D))[(size_t)row * 256 + col] = 0; }
    }
}

__device__ __forceinline__ void norm_phase(const float* x, bf16* hn, float* rss) {
    const int tid = opaque_tid(), lane = tid & 63, wave = tid >> 6;
    const int gw = blockIdx.x * 8 + wave, NGW = gridDim.x * 8;
    for (int row = gw; row < M; row += NGW) {
        const f32x4* xr = (const f32x4*)(x + (size_t)row * D) + lane;
        f32x4 v[4]; float sq = 0.f;
#pragma unroll
        for (int j = 0; j < 4; ++j) { v[j] = xr[64 * j]; sq += (v[j][0] * v[j][0] + v[j][1] * v[j][1]) + (v[j][2] * v[j][2] + v[j][3] * v[j][3]); }
        sq = wave_sum(sq);
        if (lane < 16) rss[(size_t)row * 16 + lane] = (lane == 0) ? sq : 0.f;
        v2u* o8 = (v2u*)(hn + (size_t)row * D) + lane;
#pragma unroll
        for (int j = 0; j < 4; ++j) { v2u w; w.x = pk2(v[j][0], v[j][1]); w.y = pk2(v[j][2], v[j][3]); o8[64 * j] = w; }
    }
}

constexpr int KPITCH = 72;
constexpr int AL_KS0 = 0, AL_KS1 = 9216, AL_VT0 = 36864, AL_VT1 = 54272, AL_LUT = 73728, AL_CB = 75776, AL_SCAN = 83968, AL_ITEM = 84032, AL_O0 = 86016;
constexpr float NEG_BIG = -1.0e4f;

template <int DV> struct TileRegs { v4u k; v4u v[DV / 64]; };

template <int DV> __device__ __forceinline__ void tile_load(TileRegs<DV>& R, const bf16* Kp, int kpitch, const bf16* Vp, int vpitch, int k0, int tid) {
    const int key = tid >> 3, c = tid & 7;
    R.k = *(const v4u*)(Kp + (unsigned)((k0 + key) * kpitch + 8 * c));
#pragma unroll
    for (int i = 0; i < DV / 64; ++i) R.v[i] = *(const v4u*)(Vp + (unsigned)((k0 + key) * vpitch + 64 * i + 8 * c));
}
template <int DV> __device__ __forceinline__ void tile_store(const TileRegs<DV>& R, LAS unsigned char* ks, LAS unsigned char* vt, int tid) {
    const int key = tid >> 3, c = tid & 7;
    *(LAS v4u*)(ks + (key * KPITCH + 8 * c) * 2) = R.k;
#pragma unroll
    for (int i = 0; i < DV / 64; ++i) *(LAS v4u*)(vt + (key * (DV + 8) + 64 * i + 8 * c) * 2) = R.v[i];
}
__device__ __forceinline__ bf16x8 pack8(const f32x16& s, int st) {
    v4u w;
    if (st == 0) { w.x = pk2(s[0], s[1]); w.y = pk2(s[2], s[3]); w.z = pk2(s[4], s[5]); w.w = pk2(s[6], s[7]); }
    else         { w.x = pk2(s[8], s[9]); w.y = pk2(s[10], s[11]); w.z = pk2(s[12], s[13]); w.w = pk2(s[14], s[15]); }
    return __builtin_bit_cast(bf16x8, w);
}
typedef short v4i16_t __attribute__((ext_vector_type(4)));
template <int DV> __device__ __forceinline__ bf16x8 vfrag(LAS unsigned char* vt, int dv0, int kbase, int lane) {
    const int i16 = lane & 15, q = i16 >> 2, pp_ = i16 & 3, blk = (lane >> 4) & 1;
    LAS unsigned char* p0 = vt + ((kbase + q) * (DV + 8) + dv0 + 16 * blk + 4 * pp_) * 2;
    const v4i16_t lo = __builtin_amdgcn_ds_read_tr16_b64_v4i16((LAS v4i16_t*)p0);
    const v4i16_t hi = __builtin_amdgcn_ds_read_tr16_b64_v4i16((LAS v4i16_t*)(p0 + 8 * (DV + 8) * 2));
    return __builtin_shufflevector(lo, hi, 0, 1, 2, 3, 4, 5, 6, 7);
}
__device__ __forceinline__ int rel_bucket(int n) {
    if (n < 16) return n;
    return 16 + (n >= 19) + (n >= 21) + (n >= 24) + (n >= 27) + (n >= 31) + (n >= 35) + (n >= 40) + (n >= 46) + (n >= 52) + (n >= 59) + (n >= 67) + (n >= 77) + (n >= 87) + (n >= 99) + (n >= 113);
}

template <int KIND>
__device__ __forceinline__ void softmax_tile(f32x16& s0, f32x16& s1, float& l, int t, int k0, int h, int qlo, const LAS float* lut, const LAS float* cb, int W, int dmask, float rowshift) {
    const float NINF = -__builtin_inff();
    if (KIND == 0) {
        if (k0 + 63 + 128 <= qlo) {
            const float c = lut[128];
#pragma unroll
            for (int i = 0; i < 16; ++i) { s0[i] += c; s1[i] += c; }
        } else {
#pragma unroll
            for (int i = 0; i < 16; ++i) {
                const int j0 = k0 + (i & 3) + 8 * (i >> 2) + 4 * h, n0 = t - j0, n1 = n0 - 32;
                const float b0 = lut[min(max(n0, 0), 128)], b1 = lut[min(max(n1, 0), 128)];
                s0[i] = (n0 >= 0) ? s0[i] + b0 : NINF; s1[i] = (n1 >= 0) ? s1[i] + b1 : NINF;
            }
        }
    } else if (KIND == 1) {
        const bool diag = (k0 + 63 > qlo);
#pragma unroll
        for (int c = 0; c < 4; ++c) {
            const f32x4 b0 = *(const LAS f32x4*)(cb + k0 + 8 * c + 4 * h), b1 = *(const LAS f32x4*)(cb + k0 + 32 + 8 * c + 4 * h);
#pragma unroll
            for (int jj = 0; jj < 4; ++jj) {
                const int i = 4 * c + jj; const int n0 = t - (k0 + 8 * c + 4 * h + jj), n1 = n0 - 32;
                float x0 = s0[i] + (b0[jj] + rowshift), x1 = s1[i] + (b1[jj] + rowshift);
                if (diag) { x0 = (n0 >= 0) ? x0 : NINF; x1 = (n1 >= 0) ? x1 : NINF; }
                s0[i] = x0; s1[i] = x1;
            }
        }
    } else {
#pragma unroll
        for (int i = 0; i < 16; ++i) {
            const int j0 = k0 + (i & 3) + 8 * (i >> 2) + 4 * h, n0 = t - j0, n1 = n0 - 32;
            const float b0 = lut[min(max(n0, 0), 128)], b1 = lut[min(max(n1, 0), 128)];
            const bool v0 = (n0 >= 0) && (n0 <= W) && ((n0 & dmask) == 0), v1 = (n1 >= 0) && (n1 <= W) && ((n1 & dmask) == 0);
            s0[i] = v0 ? s0[i] + b0 : NINF; s1[i] = v1 ? s1[i] + b1 : NINF;
        }
    }
    float ps = 0.f;
#pragma unroll
    for (int i = 0; i < 16; ++i) { s0[i] = fexp2(s0[i]); s1[i] = fexp2(s1[i]); ps += s0[i] + s1[i]; }
    l += ps;
}

__device__ __forceinline__ void stick_block(f32x16& s, float& Rr, int t, int kbase, int h, bool diag) {
    float u[16], gs[4], pg[4];
#pragma unroll
    for (int i = 0; i < 16; ++i) {
        const float z = s[i];
        const float sp = fmaxf(z, 0.f) + flog2(1.0f + fexp2(-fabsf(z)));
        const int j = kbase + (i & 3) + 8 * (i >> 2) + 4 * h;
        const bool valid = !diag || (j < t);
        u[i] = valid ? -sp : 0.f;
        s[i] = valid ? (z - sp) : -__builtin_inff();
    }
#pragma unroll
    for (int c = 0; c < 4; ++c) { gs[c] = (u[4 * c] + u[4 * c + 1]) + (u[4 * c + 2] + u[4 * c + 3]); pg[c] = __shfl_xor(gs[c], 32); }
    float run = Rr;
#pragma unroll
    for (int c = 3; c >= 0; --c) {
        float tl = run + ((h == 0) ? pg[c] : 0.f);
#pragma unroll
        for (int jj = 3; jj >= 0; --jj) { const int i = 4 * c + jj; const float a = fexp2(s[i] + tl); tl += u[i]; s[i] = a; }
        run += gs[c] + pg[c];
    }
    Rr = run;
}

template <int KIND  , int DV>
__device__ __forceinline__ void attn_pass(LAS unsigned char* L, const bf16* Qp, int qpitch, const bf16* Kp, int kpitch, const bf16* Vp, int vpitch,
                                          int q0w, int t_lo, int t_hi, f32x16 (&o)[DV / 32], const float bnd, float& l, float& Rr,
                                          const LAS float* lut, const LAS float* cb, int W, int dmask, const int tid, const bool wave_on = true) {
    const int lane = tid & 63, r = lane & 31, h = lane >> 5;
    const int t = q0w + r, qlo = q0w, qhi = wave_on ? q0w + 31 : -1;
    bf16x8 qf[4];
#pragma unroll
    for (int ks = 0; ks < 4; ++ks) qf[ks] = *(const bf16x8*)(Qp + (unsigned)((wave_on ? t : 0) * qpitch + 16 * ks + 8 * h));
    TileRegs<DV> TA, TB;
    __syncthreads();
    tile_load<DV>(TA, Kp, kpitch, Vp, vpitch, t_hi * 64, tid);
    tile_store<DV>(TA, L + AL_KS0, L + AL_VT0, tid);
    if (t_hi - 1 >= t_lo) tile_load<DV>(TA, Kp, kpitch, Vp, vpitch, (t_hi - 1) * 64, tid);
    float rowshift = 0.f;
    if (KIND == 1) rowshift = -cb[t] - bnd;
    int buf = 0;
#define ATTN_STEP(TCUR, TNXT)                                                                                                          \
    {                                                                                                                                   \
        __syncthreads();                                                                                                                \
        if (tt - 2 >= t_lo) tile_load<DV>(TNXT, Kp, kpitch, Vp, vpitch, (tt - 2) * 64, tid);                                            \
        const int k0 = tt * 64;                                                                                                         \
        bool active = (k0 <= qhi);                                                                                                      \
        if (KIND == 2) active = active && (k0 + 63 >= qlo - W);                                                                         \
        if (active) {                                                                                                                   \
            LAS unsigned char* ks = L + (buf ? AL_KS1 : AL_KS0);                                                                        \
            LAS unsigned char* vt = L + (buf ? AL_VT1 : AL_VT0);                                                                        \
            f32x16 s0, s1;                                                                                                              \
            _Pragma("unroll") for (int i = 0; i < 16; ++i) { s0[i] = 0.f; s1[i] = 0.f; }                                                \
            _Pragma("unroll") for (int kk = 0; kk < 4; ++kk) {                                                                          \
                const bf16x8 a0 = *(const LAS bf16x8*)(ks + (r * KPITCH + 16 * kk + 8 * h) * 2);                                        \
                const bf16x8 a1 = *(const LAS bf16x8*)(ks + ((32 + r) * KPITCH + 16 * kk + 8 * h) * 2);                                 \
                s0 = MFMA32(a0, qf[kk], s0); s1 = MFMA32(a1, qf[kk], s1);                                                               \
            }                                                                                                                           \
            if (KIND == 3) {                                                                                                            \
                const bool diag = (k0 + 63 >= qlo);                                                                                     \
                stick_block(s1, Rr, t, k0 + 32, h, diag);                                                                               \
                stick_block(s0, Rr, t, k0, h, diag);                                                                                    \
            } else {                                                                                                                    \
                softmax_tile<KIND>(s0, s1, l, t, k0, h, qlo, lut, cb, W, dmask, rowshift);                                              \
            }                                                                                                                           \
            _Pragma("unroll") for (int st = 0; st < 2; ++st) {                                                                          \
                const bf16x8 pb = pack8(s0, st);                                                                                        \
                _Pragma("unroll") for (int db = 0; db < DV / 32; ++db) o[db] = MFMA32(vfrag<DV>(vt, 32 * db, 16 * st + 4 * h, lane), pb, o[db]);      \
            }                                                                                                                           \
            _Pragma("unroll") for (int st = 0; st < 2; ++st) {                                                                          \
                const bf16x8 pb = pack8(s1, st);                                                                                        \
                _Pragma("unroll") for (int db = 0; db < DV / 32; ++db) o[db] = MFMA32(vfrag<DV>(vt, 32 * db, 32 + 16 * st + 4 * h, lane), pb, o[db]); \
            }                                                                                                                           \
        }                                                                                                                               \
        if (tt - 1 >= t_lo) tile_store<DV>(TCUR, L + (buf ? AL_KS0 : AL_KS1), L + (buf ? AL_VT0 : AL_VT1), tid);                        \
        buf ^= 1;                                                                                                                       \
    }
    for (int tt = t_hi; tt >= t_lo; tt -= 2) {
        ATTN_STEP(TA, TB)
        if (tt - 1 < t_lo) break;
        { const int tt_save = tt; (void)tt_save; }
        tt -= 1;
        ATTN_STEP(TB, TA)
        tt += 1;
    }
#undef ATTN_STEP
}

__device__ __forceinline__ void qk_tile(LAS unsigned char* ks, const bf16x8 (&qf)[4], int r, int h, f32x16& s0, f32x16& s1) {
    bf16x8 kf[8];
#pragma unroll
    for (int kk = 0; kk < 4; ++kk) {
        kf[2 * kk]     = *(const LAS bf16x8*)(ks + (r * KPITCH + 16 * kk + 8 * h) * 2);
        kf[2 * kk + 1] = *(const LAS bf16x8*)(ks + ((32 + r) * KPITCH + 16 * kk + 8 * h) * 2);
    }
#pragma unroll
    for (int i = 0; i < 16; ++i) { s0[i] = 0.f; s1[i] = 0.f; }
#pragma unroll
    for (int kk = 0; kk < 4; ++kk) { s0 = MFMA32(kf[2 * kk], qf[kk], s0); s1 = MFMA32(kf[2 * kk + 1], qf[kk], s1); }
}
__device__ __forceinline__ void pv_tile(LAS unsigned char* vt, const f32x16& s0, const f32x16& s1, int h, int lane, f32x16 (&o)[2]) {
#pragma unroll
    for (int st = 0; st < 2; ++st) {
        const bf16x8 pb = pack8(s0, st);
#pragma unroll
        for (int db = 0; db < 2; ++db) o[db] = MFMA32(vfrag<64>(vt, 32 * db, 16 * st + 4 * h, lane), pb, o[db]);
    }
#pragma unroll
    for (int st = 0; st < 2; ++st) {
        const bf16x8 pb = pack8(s1, st);
#pragma unroll
        for (int db = 0; db < 2; ++db) o[db] = MFMA32(vfrag<64>(vt, 32 * db, 32 + 16 * st + 4 * h, lane), pb, o[db]);
    }
}
template <int KIND  >
__device__ __forceinline__ void score_tile(f32x16& s0, f32x16& s1, float& l, float& Rr, int t, int k0, int h, int qlo, const LAS float* lut, const LAS float* cb, int W, int dmask, float rowshift) {
    if (KIND == 3) { const bool diag = (k0 + 63 >= qlo); stick_block(s1, Rr, t, k0 + 32, h, diag); stick_block(s0, Rr, t, k0, h, diag); }
    else softmax_tile<KIND>(s0, s1, l, t, k0, h, qlo, lut, cb, W, dmask, rowshift);
}

template <int KIND  >
__device__ __forceinline__ void attn_pass2(LAS unsigned char* L, const bf16* Qp, int qpitch, const bf16* Kp, int kpitch, const bf16* Vp, int vpitch,
                                           int q0w, int t_lo, int t_hi, f32x16 (&o)[2], const float bnd, float& l, float& Rr,
                                           const LAS float* lut, const LAS float* cb, int W, int dmask, const int tid, const bool wave_on = true) {
    const int lane = tid & 63, r = lane & 31, h = lane >> 5;
    const int t = q0w + r, qlo = q0w, qhi = wave_on ? q0w + 31 : -1;
    bf16x8 qf[4];
#pragma unroll
    for (int ks = 0; ks < 4; ++ks) qf[ks] = *(const bf16x8*)(Qp + (unsigned)((wave_on ? t : 0) * qpitch + 16 * ks + 8 * h));
    TileRegs<64> TA, TB;
    __syncthreads();
    tile_load<64>(TA, Kp, kpitch, Vp, vpitch, t_hi * 64, tid);
    if (t_hi - 1 >= t_lo) tile_load<64>(TB, Kp, kpitch, Vp, vpitch, (t_hi - 1) * 64, tid);
    tile_store<64>(TA, L + 0, L + 36864, tid);
    if (t_hi - 1 >= t_lo) tile_store<64>(TB, L + 9216, L + 36864 + 9216, tid);
    if (t_hi - 2 >= t_lo) tile_load<64>(TA, Kp, kpitch, Vp, vpitch, (t_hi - 2) * 64, tid);
    if (t_hi - 3 >= t_lo) tile_load<64>(TB, Kp, kpitch, Vp, vpitch, (t_hi - 3) * 64, tid);
    float rowshift = 0.f;
    if (KIND == 1) rowshift = -cb[t] - bnd;
    volatile LAS int* dflag = (volatile LAS int*)(L + AL_ITEM + 32);
    const int wv = tid >> 6;
    if (KIND == 3 && lane == 0) { dflag[wv] = 0; dflag[8 + wv] = 0; }
    bool wdone = false; int it = 0;
    int par = 0;
    for (int tt = t_hi; tt >= t_lo; tt -= 2, ++it) {
        __syncthreads();
        if (KIND == 3) {
            const int rb = ((it + 1) & 1) * 8;
            const int alld = dflag[rb] & dflag[rb + 1] & dflag[rb + 2] & dflag[rb + 3] & dflag[rb + 4] & dflag[rb + 5] & dflag[rb + 6] & dflag[rb + 7];
            if (alld) break;
        }
        const int k0a = tt * 64, k0b = k0a - 64;
        bool actA = (k0a <= qhi), actB = (tt - 1 >= t_lo) && (k0b <= qhi);
        if (KIND == 2) { actA = actA && (k0a + 63 >= qlo - W); actB = actB && (k0b + 63 >= qlo - W); }
        if (KIND == 3) { actA = actA && !wdone; actB = actB && !wdone; }
        if (KIND == 1) {
            actA = actA && (cb[k0a + 63] - cb[qlo] >= -152.0f); actB = actB && (k0b >= 0) && (cb[max(k0b, 0) + 63] - cb[qlo] >= -152.0f); }
        LAS unsigned char* ksA = L + par * 9216;       LAS unsigned char* vtA = L + 36864 + par * 9216;
        LAS unsigned char* ksB = L + (par + 1) * 9216; LAS unsigned char* vtB = L + 36864 + (par + 1) * 9216;
        if (actA && actB) {
            f32x16 a0, a1, b0, b1;
            qk_tile(ksA, qf, r, h, a0, a1);
            qk_tile(ksB, qf, r, h, b0, b1);
            score_tile<KIND>(a0, a1, l, Rr, t, k0a, h, qlo, lut, cb, W, dmask, rowshift);
            pv_tile(vtA, a0, a1, h, lane, o);
            score_tile<KIND>(b0, b1, l, Rr, t, k0b, h, qlo, lut, cb, W, dmask, rowshift);
            pv_tile(vtB, b0, b1, h, lane, o);
        } else if (actA) {
            f32x16 a0, a1;
            qk_tile(ksA, qf, r, h, a0, a1);
            score_tile<KIND>(a0, a1, l, Rr, t, k0a, h, qlo, lut, cb, W, dmask, rowshift);
            pv_tile(vtA, a0, a1, h, lane, o);
        } else if (actB) {
            f32x16 b0, b1;
            qk_tile(ksB, qf, r, h, b0, b1);
            score_tile<KIND>(b0, b1, l, Rr, t, k0b, h, qlo, lut, cb, W, dmask, rowshift);
            pv_tile(vtB, b0, b1, h, lane, o);
        }
        if (KIND == 3) {
            wdone = wdone || (wave_on ? (__all(Rr < -152.0f) != 0) : true);
            if (lane == 0) dflag[(it & 1) * 8 + wv] = wdone ? 1 : 0;
        }
        const int np = par ^ 2;
        if (tt - 2 >= t_lo) tile_store<64>(TA, L + np * 9216, L + 36864 + np * 9216, tid);
        if (tt - 3 >= t_lo) tile_store<64>(TB, L + (np + 1) * 9216, L + 36864 + (np + 1) * 9216, tid);
        if (tt - 4 >= t_lo) tile_load<64>(TA, Kp, kpitch, Vp, vpitch, (tt - 4) * 64, tid);
        if (tt - 5 >= t_lo) tile_load<64>(TB, Kp, kpitch, Vp, vpitch, (tt - 5) * 64, tid);
        par = np;
    }
}

template <int NB> __device__ __forceinline__ void zero_o(f32x16 (&o)[NB]) {
#pragma unroll
    for (int b = 0; b < NB; ++b)
#pragma unroll
        for (int i = 0; i < 16; ++i) o[b][i] = 0.f;
}
__device__ __forceinline__ void store_o64(const f32x16 (&o)[2], float inv, bf16* orow, int h) {
#pragma unroll
    for (int db = 0; db < 2; ++db)
#pragma unroll
        for (int c = 0; c < 4; ++c) {
            v2u w; w.x = pk2(o[db][4 * c] * inv, o[db][4 * c + 1] * inv); w.y = pk2(o[db][4 * c + 2] * inv, o[db][4 * c + 3] * inv);
            *(v2u*)(orow + 32 * db + 8 * c + 4 * h) = w;
        }
}

constexpr int N_ABC_ITEMS = 512 + 4 * 192, N_ATT_ITEMS = N_ABC_ITEMS + 512;
constexpr size_t DP_O = 0, DP_L = (size_t)48 << 20;

__device__ __forceinline__ void attention_phase(PPtr p, int layer, LAS unsigned char* L, unsigned* counter, const bool do_store) {
    const int tid = opaque_tid(), lane = tid & 63, wave = tid >> 6, r = lane & 31, h = lane >> 5;
    unsigned char* big = p->ws + WS_BIG;
    LAS float* lut = (LAS float*)(L + AL_LUT);
    LAS float* cb = (LAS float*)(L + AL_CB);
    LAS float* scan = (LAS float*)(L + AL_SCAN);
    volatile LAS unsigned* itemw = (volatile LAS unsigned*)(L + AL_ITEM);
    const float* rel = p->in[1];
    for (;;) {
        __syncthreads();
        if (tid == 0) itemw[0] = atomicAdd(counter, 1u);
        __syncthreads();
        const int idx = (int)itemw[0];
        if (idx >= N_ATT_ITEMS) break;
        int tl_ = tid; asm volatile("" : "+v"(tl_));
        const int lane = tl_ & 63, r = lane & 31, h = lane >> 5;
        int qb, rr, dsel = 0;
        if (idx < 512) { qb = 7 - (idx >> 6); rr = idx & 63; }
        else if (idx < N_ABC_ITEMS) { const int j = idx - 512; qb = 3 - j / 192; rr = 64 + j % 192; }
        else { dsel = idx - N_ABC_ITEMS; qb = 0; rr = 256; }
#ifdef PROBE_ATT_TYPE
        if (!do_store) { const int ty = (rr < 64) ? 0 : (rr < 160 ? 1 : (rr < 256 ? 2 : 3)); if (ty != PROBE_ATT_TYPE) continue; }
#endif
        const int q0blk = qb * 256, q0w = q0blk + 32 * wave;
        const int t_hi = (q0blk + 255) >> 6;
        float dummyR = 0.f;
        if (rr < 64) {
            const int b = rr >> 2, hd = rr & 3;
            float bnd;
            {
                float mq = fabsf(p->in[9][layer * 64 + lane]), mk = fabsf(p->in[10][layer * 64 + lane]), mb = (lane < 32) ? fabsf(rel[lane * 10 + hd]) : 0.f;
#pragma unroll
                for (int o_ = 1; o_ < 64; o_ <<= 1) { mq = fmaxf(mq, __shfl_xor(mq, o_)); mk = fmaxf(mk, __shfl_xor(mk, o_)); mb = fmaxf(mb, __shfl_xor(mb, o_)); }
                bnd = 64.f * mq * mk * QSCALE * 1.02f + mb * LOG2E + 0.5f;
            }
            if (tid <= 128) lut[tid] = rel[rel_bucket(tid) * 10 + hd] * LOG2E - bnd;
            const float* lv = p->in[11] + (size_t)layer * 256;
            const float lam = expf(wave_sum(lv[lane] * lv[64 + lane])) - expf(wave_sum(lv[128 + lane] * lv[192 + lane])) + p->lam_init[layer];
            const size_t rowb = (size_t)b * S;
            bf16* QA = (bf16*)(big + B_QA) + rowb * 512 + hd * 128;
            const bf16* KA = (const bf16*)(big + B_KA) + rowb * 512 + hd * 128;
            const bf16* VA = (const bf16*)(big + B_VA) + rowb * 512 + hd * 128;
            LAS unsigned* o0p = (LAS unsigned*)(L + AL_O0) + tid;
            f32x16 o[4]; float l;
            zero_o<4>(o); l = 0.f;
            attn_pass<0, 128>(L, QA, 512, KA, 512, VA, 512, q0w, 0, t_hi, o, bnd, l, dummyR, lut, cb, 0, 0, tid);
            { const float inv = 1.0f / (l + __shfl_xor(l, 32));
#pragma unroll
              for (int db = 0; db < 4; ++db)
#pragma unroll
                  for (int i = 0; i < 8; ++i) o0p[(db * 8 + i) * NTHREADS] = pk2(o[db][2 * i] * inv, o[db][2 * i + 1] * inv); }
            zero_o<4>(o); l = 0.f;
            attn_pass<0, 128>(L, QA + 64, 512, KA + 64, 512, VA, 512, q0w, 0, t_hi, o, bnd, l, dummyR, lut, cb, 0, 0, tid);
            { const float inv = lam / (l + __shfl_xor(l, 32));
              float ss = 0.f;
#pragma unroll
              for (int db = 0; db < 4; ++db)
#pragma unroll
                  for (int i = 0; i < 8; ++i) {
                      const unsigned w0 = o0p[(db * 8 + i) * NTHREADS];
                      const float a = bflo(w0) - o[db][2 * i] * inv, c = bfhi(w0) - o[db][2 * i + 1] * inv;
                      o[db][2 * i] = a; o[db][2 * i + 1] = c; ss += a * a + c * c;
                  }
              ss += __shfl_xor(ss, 32);
              const float rs = rsqrtf(ss * (1.0f / 128.0f) + RMS_EPS) * p->one_minus_lam_init[layer];
              const float* sg = p->in[12] + (size_t)layer * 128;
              bf16* orow = QA + (size_t)(q0w + r) * 512;
              if (do_store)
#pragma unroll
              for (int db = 0; db < 4; ++db)
#pragma unroll
                  for (int c = 0; c < 4; ++c) {
                      const int dv = 32 * db + 8 * c + 4 * h;
                      const f32x4 g4 = *(const f32x4*)(sg + dv);
                      v2u w; w.x = pk2(o[db][4 * c] * rs * g4[0], o[db][4 * c + 1] * rs * g4[1]); w.y = pk2(o[db][4 * c + 2] * rs * g4[2], o[db][4 * c + 3] * rs * g4[3]);
                      *(v2u*)(orow + dv) = w;
                  }
            }
        } else if (rr < 160) {
            const int q = rr - 64, b = q / 6, hd = q % 6;
            const size_t rowb = (size_t)b * S;
            bf16* QB = (bf16*)(big + B_QB) + rowb * 384 + hd * 64;
            const bf16* KB = (const bf16*)(big + B_KB) + rowb * 384 + hd * 64;
            const bf16* VB = (const bf16*)(big + B_VB) + rowb * 384 + hd * 64;
#pragma unroll 1
            for (int sub = 0; sub < 2; ++sub) {
                const int q0b_s = (2 * qb + 1 - sub) * 256, q0w_s = q0b_s + 32 * wave, thi_s = (q0b_s + 255) >> 6;
                f32x16 o[2]; float l = 0.f, Rr = 0.f;
                zero_o<2>(o);
                attn_pass2<3>(L, QB, 384, KB, 384, VB, 384, q0w_s, 0, thi_s, o, 0.f, l, Rr, lut, cb, 0, 0, tid);
                if (do_store) store_o64(o, 1.0f, QB + (size_t)(q0w_s + r) * 384, h);
            }
        } else if (rr < 256) {
            const int q = rr - 160, b = q / 6, hd = q % 6;
            const size_t rowb = (size_t)b * S;
            {
                const int qend = (2 * qb + 2) * 256;
                const float* lf = (const float*)(p->ws + WS_LOGF) + rowb * 8 + hd;
                int tq = tid; asm volatile("" : "+v"(tq));
                float v[4];
#pragma unroll
                for (int i = 0; i < 4; ++i) { const int tok = 4 * tq + i; v[i] = (tok < qend) ? lf[(size_t)tok * 8] : 0.f; }
                v[1] += v[0]; v[2] += v[1]; v[3] += v[2];
                float incl = v[3];
#pragma unroll
                for (int off = 1; off < 64; off <<= 1) { const float y = __shfl_up(incl, off); if (lane >= off) incl += y; }
                if (lane == 63) scan[wave] = incl;
                __syncthreads();
                float pre = incl - v[3];
                for (int w2 = 0; w2 < wave; ++w2) pre += scan[w2];
#pragma unroll
                for (int i = 0; i < 4; ++i) cb[4 * tid + i] = -(pre + v[i]) * LOG2E;
            }
            bf16* QC = (bf16*)(big + B_QC) + rowb * 384 + hd * 64;
            const bf16* KC = (const bf16*)(big + B_KC) + rowb * 384 + hd * 64;
            const bf16* VC = (const bf16*)(big + B_VC) + rowb * 384 + hd * 64;
            float bnd;
            {   float mq = fabsf(p->in[13][layer * 64 + lane]), mk = fabsf(p->in[14][layer * 64 + lane]);
#pragma unroll
                for (int o_ = 1; o_ < 64; o_ <<= 1) { mq = fmaxf(mq, __shfl_xor(mq, o_)); mk = fmaxf(mk, __shfl_xor(mk, o_)); }
                bnd = 64.f * mq * mk * QSCALE * 1.02f + 0.5f; }
            __syncthreads();
#pragma unroll 1
            for (int sub = 0; sub < 2; ++sub) {
                const int q0b_s = (2 * qb + 1 - sub) * 256, q0w_s = q0b_s + 32 * wave, thi_s = (q0b_s + 255) >> 6;
                f32x16 o[2]; float l = 0.f;
                zero_o<2>(o);
                int tlc = 0;
                while (tlc < thi_s && (cb[64 * tlc + 63] - cb[q0b_s] < -152.0f)) ++tlc;
                attn_pass2<1>(L, QC, 384, KC, 384, VC, 384, q0w_s, tlc, thi_s, o, bnd, l, dummyR, lut, cb, 0, 0, tid);
                const float inv = 1.0f / (l + __shfl_xor(l, 32));
                if (do_store) store_o64(o, inv, QC + (size_t)(q0w_s + r) * 384, h);
            }
        } else {
            int g, dd, bh, rsel, npass;
            if (dsel < 256)      { g = 0; dd = 1;  bh = dsel & 31; rsel = 7 - (dsel >> 5); npass = 1; }
            else if (dsel < 384) { const int j = dsel - 256; g = 1; dd = 4;  bh = j & 31; rsel = j >> 5; npass = 2; }
            else                 { const int j = dsel - 384; g = 2; dd = 16; bh = j & 31; rsel = j >> 5; npass = 4; }
            const int b = bh >> 1, hs = bh & 1, Sv = S / dd;
            const size_t rowb = (size_t)b * S;
            float bnd;
            {   float mq = fabsf(p->in[15][layer * 64 + lane]), mk = fabsf(p->in[16][layer * 64 + lane]);
                float mb = (lane < 32) ? fmaxf(fmaxf(fabsf(rel[lane * 10 + 4 + hs]), fabsf(rel[lane * 10 + 6 + hs])), fabsf(rel[lane * 10 + 8 + hs])) : 0.f;
#pragma unroll
                for (int o_ = 1; o_ < 64; o_ <<= 1) { mq = fmaxf(mq, __shfl_xor(mq, o_)); mk = fmaxf(mk, __shfl_xor(mk, o_)); mb = fmaxf(mb, __shfl_xor(mb, o_)); }
                bnd = 64.f * mq * mk * QSCALE * 1.02f + mb * LOG2E + 0.5f; }
            if (tid <= 128) lut[tid] = rel[rel_bucket(min(dd * tid, 2047)) * 10 + 4 + 2 * g + hs] * LOG2E - bnd;
            const int col = (2 * g + hs) * 64;
#pragma unroll 1
            for (int pi = 0; pi < npass; ++pi) {
                const int rho = (g == 0) ? 0 : (g == 1 ? rsel : rsel + 4 * pi);
                const int q0v = (g == 0) ? rsel * 256 : (g == 1 ? (1 - pi) * 256 : 0);
                const bf16* QD = (const bf16*)(big + B_QD) + (rowb + rho) * 384 + col;
                const bf16* KD = (const bf16*)(big + B_KD) + (rowb + rho) * 384 + col;
                const bf16* VD = (const bf16*)(big + B_VD) + (rowb + rho) * 384 + col;
                const int q0wv = q0v + 32 * wave;
                const bool won = q0wv < Sv;
                const int thv = (min(q0v + 255, Sv - 1)) >> 6, tlv = max(0, q0v - 128) >> 6;
                f32x16 o[2]; float l = 0.f;
                zero_o<2>(o);
                attn_pass<2, 64>(L, QD, 384 * dd, KD, 384 * dd, VD, 384 * dd, q0wv, tlv, thv, o, bnd, l, dummyR, lut, cb, 128, 0, tid, won);
                const float lt = l + __shfl_xor(l, 32);
                if (won && do_store) {
                    const size_t tok = rowb + rho + (size_t)dd * (q0wv + r);
                    float* po = (float*)((unsigned char*)p->out + DP_O) + ((size_t)g * M + tok) * 128 + hs * 64;
#pragma unroll
                    for (int db = 0; db < 2; ++db)
#pragma unroll
                        for (int c = 0; c < 4; ++c) *(f32x4*)(po + 32 * db + 8 * c + 4 * h) = (f32x4){o[db][4 * c], o[db][4 * c + 1], o[db][4 * c + 2], o[db][4 * c + 3]};
                    if (h == 0) ((float*)((unsigned char*)p->out + DP_L))[((size_t)g * M + tok) * 2 + hs] = lt;
                }
            }
        }
    }
}

__device__ __forceinline__ void dcombine_phase(float* dout, bf16* od) {
    const int tid = opaque_tid();
    const float* PO = (const float*)((unsigned char*)dout + DP_O); const float* PL = (const float*)((unsigned char*)dout + DP_L);
    for (int u = blockIdx.x * NTHREADS + tid; u < M * 32; u += gridDim.x * NTHREADS) {
        const int tok = u >> 5, c0 = (u & 31) * 8;
        v4u w = {0u, 0u, 0u, 0u};
        if (c0 < 128) {
            const int hs = c0 >> 6;
            f32x4 a = {0.f, 0.f, 0.f, 0.f}, bq = a; float lsum = 0.f;
#pragma unroll
            for (int g = 0; g < 3; ++g) {
                const float* q = PO + ((size_t)g * M + tok) * 128 + c0;
                a = a + *(const f32x4*)q; bq = bq + *(const f32x4*)(q + 4);
                lsum += PL[((size_t)g * M + tok) * 2 + hs];
            }
            const float inv = 1.0f / lsum;
            w.x = pk2(a[0] * inv, a[1] * inv); w.y = pk2(a[2] * inv, a[3] * inv); w.z = pk2(bq[0] * inv, bq[1] * inv); w.w = pk2(bq[2] * inv, bq[3] * inv);
        }
        *(v4u*)(od + (size_t)tok * 256 + c0) = w;
    }
}

#define XB_TMO      128
#define XB_XCNT(j)  (256  + 64 * (j))
#define XB_XSUB(j)  (1280 + 64 * (j))
#define XB_XGEN(j)  (2304 + 64 * (j))
#define XB_TOP      3328
#define XB_TOPGEN   3392
#define XCD_BAR_WORDS 3456
#define XB_SPIN_CAP (1u << 18)

__device__ __forceinline__ unsigned xb_ld(unsigned* p)              { return __hip_atomic_load(p, __ATOMIC_RELAXED, __HIP_MEMORY_SCOPE_AGENT); }
__device__ __forceinline__ unsigned xb_add(unsigned* p, unsigned v) { return __hip_atomic_fetch_add(p, v, __ATOMIC_RELAXED, __HIP_MEMORY_SCOPE_AGENT); }
__device__ __forceinline__ unsigned xb_xcc_id() { return (unsigned)__builtin_amdgcn_s_getreg((3 << 11) | 20) & 0xFu; }
#define XB_SPIN(cond, bar) do { unsigned _sp = 0; while (cond) { __builtin_amdgcn_s_sleep(1); \
    if ((++_sp & 255u) == 0u) { if (xb_ld(&(bar)[XB_TMO])) break; if (_sp > XB_SPIN_CAP) { atomicAdd(&(bar)[XB_TMO], 1u); break; } } } } while (0)

struct XcdBarrier {
    unsigned* bar; unsigned x;
    volatile LAS unsigned* st;
};

__device__ __forceinline__ XcdBarrier xcd_barrier_post(unsigned* bar, volatile LAS unsigned* st) {
    XcdBarrier b; b.bar = bar; b.x = xb_xcc_id(); b.st = st;
    if (threadIdx.x == 0) (void)xb_add(&bar[XB_XCNT(b.x)], 1u);
    return b;
}
__device__ __forceinline__ void xcd_barrier_complete(unsigned* bar, unsigned x, unsigned& nloc, unsigned& nx) {
    const unsigned G = gridDim.x * gridDim.y * gridDim.z;
    unsigned sum, cnt, mine, sp = 0u;
    for (;;) {
        sum = 0u; cnt = 0u; mine = 0u;
#pragma unroll
        for (unsigned j = 0; j < 16; ++j) { const unsigned c = xb_ld(&bar[XB_XCNT(j)]); sum += c; cnt += (c > 0u) ? 1u : 0u; mine = (j == x) ? c : mine; }
        if (sum == G) break;
        __builtin_amdgcn_s_sleep(1);
        if ((++sp & 255u) == 0u) { if (xb_ld(&bar[XB_TMO])) break; if (sp > XB_SPIN_CAP) { atomicAdd(&bar[XB_TMO], 1u); break; } }
    }
    nloc = mine > 0u ? mine : 1u; nx = cnt > 0u ? cnt : 1u;
}

__device__ __forceinline__ void xcd_barrier(const XcdBarrier& b) {
    asm volatile("s_waitcnt vmcnt(0)" ::: "memory");
    __syncthreads();
    if (threadIdx.x == 0) {
        unsigned* bar = b.bar;
        __builtin_amdgcn_s_waitcnt(0);
        unsigned nloc = b.st[0], nx = b.st[1];
        if (nloc == 0u) { xcd_barrier_complete(bar, b.x, nloc, nx); b.st[0] = nloc; b.st[1] = nx; }
        const unsigned old = xb_add(&bar[XB_XSUB(b.x)], 1u);
        const unsigned gen = old / nloc;
        if (old + 1u == (gen + 1u) * nloc) {
            __builtin_amdgcn_fence(__ATOMIC_RELEASE, "agent");
            asm volatile("s_waitcnt vmcnt(0)" ::: "memory");
            const unsigned og = xb_add(&bar[XB_TOP], 1u);
            const unsigned tg = og / nx;
            if (og + 1u == (tg + 1u) * nx) xb_add(&bar[XB_TOPGEN], 1u);
            else XB_SPIN(xb_ld(&bar[XB_TOPGEN]) == tg, bar);
            __builtin_amdgcn_fence(__ATOMIC_ACQUIRE, "agent");
            xb_add(&bar[XB_XGEN(b.x)], 1u);
            asm volatile("s_waitcnt vmcnt(0)" ::: "memory");
        } else {
            XB_SPIN(xb_ld(&bar[XB_XGEN(b.x)]) == gen, bar);
            __builtin_amdgcn_fence(__ATOMIC_ACQUIRE, "agent");
            asm volatile("s_waitcnt vmcnt(0)" ::: "memory");
        }
    }
    __syncthreads();
}

struct EpiAny {
    static constexpr bool PERM = true, AFTER_DRAIN = false;
    PPtr pp; LAS unsigned char* lds; int kind, layer, bi; float* outf; float scale; const float* rss_in; float* rss_out;
    __device__ __forceinline__ void operator()(AccRef acc, const pg8::Unit& u, int wr, int wc, int fr, int fq) const {
        asm volatile("" : "+v"(fr), "+v"(fq));
        unsigned char* ws = pp->ws; unsigned char* big = ws + WS_BIG;
        LAS float* rst = (LAS float*)(lds + 131072 + 256);
        if (kind == 0 || kind == 2 || kind == 4) {
            const int t = opaque_tid();
            if (t < 256) rst[t] = row_rs(rss_in, u.pm * 256 + t);
            __syncthreads();
        }
        if (kind == 0) { EpiSwiglu E{(bf16*)big, rst}; E(acc, u, wr, wc, fr, fq); }
        else if (kind == 1) { EpiResid E{(bf16*)(ws + WS_HN), outf, scale, rss_out}; E(acc, u, wr, wc, fr, fq); }
        else if (kind == 2) {
            const int l = layer;
            EpiQKV E{big, pp->in[9] + l * 64, pp->in[10] + l * 64, pp->in[13] + l * 64, pp->in[14] + l * 64, pp->in[15] + l * 64, pp->in[16] + l * 64, pp->in[8] + l * 6, (float*)(ws + WS_LOGF), rst};
            E(acc, u, wr, wc, fr, fq);
        }
        else if (kind == 3) { EpiPStore E{(v4u*)(big + B_P)}; E(acc, u, wr, wc, fr, fq); }
        else { EpiGate E{pp->in[7] + (size_t)layer * 4 * D + (size_t)bi * D, (const v4u*)(big + B_P), (v4u*)(big + B_TMP), (bf16*)(big + B_MRG), bi == 0, bi == 3, rst}; E(acc, u, wr, wc, fr, fq); }
    }
};

constexpr int STEPS_PER_LAYER = 16, CW_BAR = 4096;
#ifndef PROBE_STEP
#define PROBE_STEP (-1)
#endif
#ifndef PROBE_SYNCS
#define PROBE_SYNCS 0
#endif
__global__ void __launch_bounds__(NTHREADS, 2) mega_fwd(Params p) {
    extern __shared__ __attribute__((aligned(16))) unsigned char lds_raw[];
    LAS unsigned char* lds = (LAS unsigned char*)lds_raw;
    cg::grid_group grid = cg::this_grid();

    if (blockIdx.x == 0) for (int i = threadIdx.x; i < CW_BAR + XCD_BAR_WORDS; i += NTHREADS) ((unsigned*)(p.ws + WS_CTL))[i] = 0u;
    volatile LAS unsigned* bst = (volatile LAS unsigned*)(lds + LDS_BST);
    if (threadIdx.x < 2) bst[threadIdx.x] = 0u;
    prologue_weights(p, lds);
#ifdef PROBE_PROLOGUE
    prologue_weights(p, lds);
#endif
    norm_phase(p.in[0], (bf16*)(p.ws + WS_HN), (float*)(p.ws + WS_RSP));
    grid.sync();
    (void)xcd_barrier_post((unsigned*)(p.ws + WS_CTL) + CW_BAR, bst);

    constexpr int SPL = STEPS_PER_LAYER + ((PROBE_STEP >= 0) ? 1 : 0);
#pragma unroll 1
    for (int step = 0; step < 2 * SPL; ++step) {
        const int l = step / SPL; int k = step % SPL; bool dry = false;
        if (PROBE_STEP >= 0) { if (k == PROBE_STEP) dry = true; else if (k > PROBE_STEP) k -= 1; }
        PPtr pp = (PPtr)__builtin_amdgcn_kernarg_segment_ptr(); asm volatile("" : "+s"(pp));
        unsigned char* ws = pp->ws;
        unsigned char* wb = ws + WS_W + (size_t)l * W_LAYER;
        unsigned char* big = ws + WS_BIG;
        bf16* HN = (bf16*)(ws + WS_HN);
        float* xres = pp->out;
        float* rssb = (float*)(ws + WS_RSP);
        bool is_att = false, is_comb = false, sync_after = true;
        const bf16* A = HN; const bf16* Bt = (const bf16*)wb; int N = D, K = D;
        EpiAny E; E.pp = pp; E.lds = lds; E.kind = 1; E.layer = l; E.bi = 0; E.outf = nullptr; E.scale = 1.0f; E.rss_in = rssb; E.rss_out = rssb;
        if (k == 0)       { A = HN; Bt = (const bf16*)(wb + W_1T); N = 2 * FF; K = D; E.kind = 0; E.rss_in = rssb; }
        else if (k == 1)  { A = (const bf16*)big; Bt = (const bf16*)(wb + W_2T); N = D; K = FF; E.kind = 1; E.scale = 0.5f; }
        else if (k == 2)  { A = HN; Bt = (const bf16*)(wb + W_INT); N = NQKV; K = D; E.kind = 2; E.rss_in = rssb; }
        else if (k == 3)  { is_att = true; }
        else if (k == 4)  { is_comb = true; }
        else if (k < 13)  {
            const int i = (k - 5) >> 1;
            E.bi = i;
            if (((k - 5) & 1) == 0) {
                const size_t aoff = (i == 0) ? B_QA : (i == 1 ? B_QB : (i == 2 ? B_QC : B_OD));
                const size_t woff = (i == 0) ? WB_A : (i == 1 ? WB_B : (i == 2 ? WB_C : WB_D));
                A = (const bf16*)(big + aoff); Bt = (const bf16*)(wb + W_BRT + woff); N = D; K = (i == 0) ? 512 : (i == 3 ? 256 : 384); E.kind = 3;
            } else {
                A = HN; Bt = (const bf16*)(wb + W_GT) + (size_t)i * D * D; N = D; K = D; E.kind = 4; E.rss_in = rssb;
            }
            sync_after = (k == 12);
        }
        else if (k == 13) { A = (const bf16*)(big + B_MRG); Bt = (const bf16*)(wb + W_OT); N = D; K = D; E.kind = 1; E.scale = 1.0f; }
        else if (k == 14) { A = HN; Bt = (const bf16*)(wb + W_3T); N = 2 * FF; K = D; E.kind = 0; E.rss_in = rssb; }
        else              { A = (const bf16*)big; Bt = (const bf16*)(wb + W_4T); N = D; K = FF; E.kind = 1; E.scale = 0.5f; if (l == 1) E.outf = xres; }

        if (is_comb) {
            dcombine_phase(xres, (bf16*)(big + B_OD));
        } else if (!is_att) {
            if (dry && E.kind == 1) { E.scale = 0.f; E.outf = nullptr; }
            pg8::Gemm g{A, Bt, M, N, K}; pg8::StaticOrder So; So.init(M, N, (int)gridDim.x, (int)blockIdx.x);
            pg8::gemm_phase<EpiAny, pg8::StaticOrder, true, true>(lds, g, So, E);
        } else {
            attention_phase(pp, l, lds, (unsigned*)(ws + WS_CTL) + l + (dry ? 2 : 0), !dry);
        }
        if (step == 2 * SPL - 1) sync_after = false;
        if (dry || sync_after) {
            XcdBarrier xb; xb.bar = (unsigned*)(ws + WS_CTL) + CW_BAR; xb.x = xb_xcc_id(); xb.st = (volatile LAS unsigned*)(lds + LDS_BST);
            int nb = 1;
            if (PROBE_SYNCS > 0 && k == 0) nb += PROBE_SYNCS;
#pragma unroll 1
            for (int i = 0; i < nb; ++i) xcd_barrier(xb);
        }
    }
}

extern "C" void kernel_launch(void* const* d_in, const int* in_sizes, int n_in, void* d_out, int out_size, void* d_ws, size_t ws_size, hipStream_t stream) {
    static int grid = 0;
    if (grid == 0) {
        if (n_in != 22 || out_size != M * D || ws_size < WS_END) { fprintf(stderr, "kernel_launch: unexpected shapes (n_in %d, out %d, ws %zu)\n", n_in, out_size, ws_size); grid = -1; return; }
        int dev = 0, cus = 0, per_cu = 0;
        hipGetDevice(&dev);
        hipDeviceGetAttribute(&cus, hipDeviceAttributeMultiprocessorCount, dev);
        if (hipFuncSetAttribute((const void*)mega_fwd, hipFuncAttributeMaxDynamicSharedMemorySize, LDS_BYTES) != hipSuccess) fprintf(stderr, "kernel_launch: hipFuncSetAttribute failed\n");
        if (hipOccupancyMaxActiveBlocksPerMultiprocessor(&per_cu, (const void*)mega_fwd, NTHREADS, LDS_BYTES) != hipSuccess || per_cu < 1) per_cu = 1;
        (void)hipGetLastError();
        grid = cus * per_cu;
    }
    if (grid < 0) return;
    Params p{};
    for (int i = 0; i < 22; ++i) p.in[i] = (const float*)d_in[i];
    p.out = (float*)d_out; p.ws = (unsigned char*)d_ws;
    for (int l = 0; l < 2; ++l) { const double li = 0.8 - 0.6 * exp(-0.3 * (double)l); p.lam_init[l] = (float)li; p.one_minus_lam_init[l] = (float)(1.0 - li); }
    void* args[] = {&p};
    hipError_t e = hipLaunchCooperativeKernel((const void*)mega_fwd, dim3(grid), dim3(NTHREADS), args, LDS_BYTES, stream);
    if (e != hipSuccess) fprintf(stderr, "cooperative launch failed: %s (grid %d)\n", hipGetErrorString(e), grid);
}
```
